# Optimizing an MI355X kernel written in HIP

```python
import math
import jax
import jax.numpy as jnp
from jax import lax
import numpy as np


D_MODEL = 1024
BATCH = 4
SEQ = 4096
DEPTH = 4

N_EVEN = (DEPTH + 1) // 2
N_ODD = DEPTH // 2
ALPHA_DN = (2 * DEPTH) ** 0.25
BETA_DN = (8 * DEPTH) ** -0.25
LN_EPS = 1e-5
RMS_EPS = 1e-6

N_BUCKETS = 32
MAX_DISTANCE = 1024
N_ATT_HEADS = 8
QUERY_CHUNK = 32

MOBA_HEADS = N_ATT_HEADS
MOBA_HEAD_DIM = 64
MOBA_BLOCK = 256
MOBA_TOPK = 3
MOBA_WIDTH = MOBA_HEADS * MOBA_HEAD_DIM

GLA_HEADS = 4
GLA_DK = 64
GLA_DV = 128
GLA_GATE_RANK = 16
GLA_TAU = 16.0
GLA_CHUNK = 64
GLA_QK_WIDTH = GLA_HEADS * GLA_DK
GLA_V_WIDTH = GLA_HEADS * GLA_DV

AB_IN_SIZES = (MOBA_WIDTH, MOBA_WIDTH, MOBA_WIDTH, GLA_QK_WIDTH, GLA_QK_WIDTH, GLA_V_WIDTH, GLA_V_WIDTH, GLA_GATE_RANK)
AB_IN_WIDTH = sum(AB_IN_SIZES)
AB_OUT_WIDTH = MOBA_WIDTH + GLA_V_WIDTH

NSA_HEADS = N_ATT_HEADS
NSA_KV_GROUPS = 2
NSA_HEAD_DIM = 128
NSA_CMP_LEN = 32
NSA_CMP_STRIDE = 16
NSA_SLC_BLOCK = 64
NSA_SLC_TOPN = 16
NSA_WINDOW = 512
NSA_Q_WIDTH = NSA_HEADS * NSA_HEAD_DIM
NSA_KV_WIDTH = NSA_KV_GROUPS * NSA_HEAD_DIM
NSA_IN_SIZES = (NSA_Q_WIDTH,) + (NSA_KV_WIDTH,) * 6 + (NSA_HEADS * 3,)
NSA_IN_WIDTH = sum(NSA_IN_SIZES)

D_FF = 2816
N_EXPERTS = 8
TOP_K = 2
D_FF_EXPERT = 3584
MOE_ROW_BLOCK = 512

kernel_name = "hybrid_moba_gla_nsa_moe_deepnorm"


def _split(a, sizes):
    cuts = np.cumsum(sizes)[:-1].tolist()
    return jnp.split(a, cuts, axis=-1)


def layer_norm(x, g, b):
    xf = x.astype(jnp.float32)
    mu = jnp.mean(xf, axis=-1, keepdims=True)
    var = jnp.mean(jnp.square(xf - mu), axis=-1, keepdims=True)
    return ((xf - mu) * lax.rsqrt(var + LN_EPS) * g.astype(jnp.float32) + b.astype(jnp.float32)).astype(x.dtype)


def t5_bucket(dist):
    max_exact = N_BUCKETS // 2
    n = jnp.maximum(dist, 0)
    nf = jnp.maximum(n, 1).astype(jnp.float32)
    large = max_exact + (jnp.log(nf / max_exact) / math.log(MAX_DISTANCE / max_exact) * (N_BUCKETS - max_exact)).astype(jnp.int32)
    large = jnp.minimum(large, N_BUCKETS - 1)
    return jnp.where(n < max_exact, n, large)


def masked_softmax(logits, mask):
    l = jnp.where(mask, logits.astype(jnp.float32), -jnp.inf)
    m = jnp.max(l, axis=-1, keepdims=True)
    m = jnp.where(jnp.isfinite(m), m, 0.0)
    p = jnp.exp(l - m)
    return p / jnp.maximum(jnp.sum(p, axis=-1, keepdims=True), jnp.finfo(jnp.float32).tiny)


def moba_attention(q, k, v, rel_bias):
    B, S, H, dh = q.shape
    nb = -(-S // MOBA_BLOCK)
    sp = nb * MOBA_BLOCK
    n_sel = min(MOBA_TOPK, nb)
    pad = ((0, 0), (0, 0), (0, sp - S), (0, 0))
    qh = q.transpose(0, 2, 1, 3) * (dh ** -0.5)
    kh = jnp.pad(k.transpose(0, 2, 1, 3), pad)
    vh = jnp.pad(v.transpose(0, 2, 1, 3), pad)
    kb = kh.reshape(B, H, nb, MOBA_BLOCK, dh)
    vb = vh.reshape(B, H, nb, MOBA_BLOCK, dh)
    k_mean = jnp.mean(kb, axis=3)
    blk = jnp.arange(nb)
    offs = jnp.arange(MOBA_BLOCK)
    b_ix = jnp.arange(B)[:, None, None, None]
    h_ix = jnp.arange(H)[None, :, None, None]
    n_g = n_sel * MOBA_BLOCK

    def chunk(q0):
        qc = lax.dynamic_slice_in_dim(qh, q0, QUERY_CHUNK, axis=2)
        t = q0 + jnp.arange(QUERY_CHUNK)
        qb = q0 // MOBA_BLOCK
        gate = jnp.einsum('bhqd,bhnd->bhqn', qc, k_mean).astype(jnp.float32)
        gate = jnp.where(blk < qb, gate, -jnp.inf)
        _, sel = lax.top_k(gate, n_sel)
        k_sel = kb[b_ix, h_ix, sel]
        v_sel = vb[b_ix, h_ix, sel]
        pos_sel = sel[..., None] * MOBA_BLOCK + offs
        s_sel = jnp.einsum('bhqd,bhqnld->bhqnl', qc, k_sel) + rel_bias[t5_bucket(t[:, None, None] - pos_sel), h_ix[..., None]]
        m_sel = jnp.broadcast_to((sel < qb)[..., None], s_sel.shape)
        k_own = lax.dynamic_slice_in_dim(kh, qb * MOBA_BLOCK, MOBA_BLOCK, axis=2)
        v_own = lax.dynamic_slice_in_dim(vh, qb * MOBA_BLOCK, MOBA_BLOCK, axis=2)
        pos_own = qb * MOBA_BLOCK + offs
        s_own = jnp.einsum('bhqd,bhld->bhql', qc, k_own) + rel_bias[t5_bucket(t[:, None] - pos_own[None, :])].transpose(2, 0, 1)
        m_own = jnp.broadcast_to(pos_own[None, :] <= t[:, None], s_own.shape)
        logits = jnp.concatenate([s_sel.reshape(B, H, QUERY_CHUNK, n_g), s_own], axis=-1)
        mask = jnp.concatenate([m_sel.reshape(B, H, QUERY_CHUNK, n_g), m_own], axis=-1)
        p = masked_softmax(logits, mask).astype(v.dtype)
        o = jnp.einsum('bhqnl,bhqnld->bhqd', p[..., :n_g].reshape(B, H, QUERY_CHUNK, n_sel, MOBA_BLOCK), v_sel)
        return o + jnp.einsum('bhql,bhld->bhqd', p[..., n_g:], v_own)

    out = lax.map(chunk, jnp.arange(0, S, QUERY_CHUNK))
    return out.transpose(1, 0, 3, 2, 4).reshape(B, S, H * dh)


def gla_attention(q, k, v, log_alpha):
    B, S, H, dk = q.shape
    dv = v.shape[-1]
    C = GLA_CHUNK
    nc = S // C

    def chunks(a):
        return a.astype(jnp.float32).reshape(B, nc, C, H, a.shape[-1]).transpose(1, 0, 3, 2, 4)

    qc = chunks(q) * (dk ** -0.5)
    kc = chunks(k)
    vc = chunks(v)
    bc = jnp.cumsum(chunks(log_alpha), axis=3)
    causal = jnp.tril(jnp.ones((C, C), dtype=bool))

    def step(state, inp):
        q_, k_, v_, b_ = inp
        b_last = b_[:, :, -1:, :]
        q_dec = q_ * jnp.exp(b_)
        attn = jnp.where(causal, jnp.einsum('bhtd,bhsd->bhts', q_dec, k_ * jnp.exp(-b_)), 0.0)
        o = jnp.einsum('bhts,bhsv->bhtv', attn, v_) + jnp.einsum('bhtd,bhdv->bhtv', q_dec, state)
        state = jnp.exp(b_last[:, :, 0, :, None]) * state + jnp.einsum('bhsd,bhsv->bhdv', k_ * jnp.exp(b_last - b_), v_)
        return state, o

    state0 = jnp.zeros((B, H, dk, dv), jnp.float32)
    _, o = lax.scan(step, state0, (qc, kc, vc, bc))
    return o.transpose(1, 0, 3, 2, 4).reshape(B, S, H, dv)


def mixer_moba_gla(h, w_in, gla_wg2, gla_bg2, gla_norm_g, w_out, rel_bias):
    B, S, _ = h.shape
    mq, mk, mv, gq, gk, gv, gr, glr = _split(h @ w_in, AB_IN_SIZES)
    y_moba = moba_attention(mq.reshape(B, S, MOBA_HEADS, MOBA_HEAD_DIM), mk.reshape(B, S, MOBA_HEADS, MOBA_HEAD_DIM),
                            mv.reshape(B, S, MOBA_HEADS, MOBA_HEAD_DIM), rel_bias)
    log_alpha = jax.nn.log_sigmoid((glr @ gla_wg2 + gla_bg2).astype(jnp.float32)) / GLA_TAU
    o = gla_attention(gq.reshape(B, S, GLA_HEADS, GLA_DK), gk.reshape(B, S, GLA_HEADS, GLA_DK),
                      gv.reshape(B, S, GLA_HEADS, GLA_DV), log_alpha.reshape(B, S, GLA_HEADS, GLA_DK))
    o = o * lax.rsqrt(jnp.mean(jnp.square(o), axis=-1, keepdims=True) + RMS_EPS)
    y_gla = (o.reshape(B, S, GLA_V_WIDTH) * gla_norm_g.astype(jnp.float32)).astype(h.dtype) * jax.nn.silu(gr)
    return jnp.concatenate([y_moba, y_gla], axis=-1) @ w_out


def _compress(kv, pos, w1, w2):
    B, S, G, dh = kv.shape
    n_cmp = (S - NSA_CMP_LEN) // NSA_CMP_STRIDE + 1
    idx = jnp.arange(n_cmp)[:, None] * NSA_CMP_STRIDE + jnp.arange(NSA_CMP_LEN)[None, :]
    blocks = kv[:, idx] + pos[:, None, :]
    blocks = blocks.transpose(0, 1, 3, 2, 4).reshape(B, n_cmp, G, NSA_CMP_LEN * dh)
    return (jax.nn.silu(blocks @ w1) @ w2).transpose(0, 2, 1, 3)


def nsa_attention(q, kc, vc, ks, vs, kw, vw, gates, rel_bias, cmp_pos, w1k, w2k, w1v, w2v):
    B, S, H, dh = q.shape
    G = kc.shape[2]
    HPG = H // G
    QC = QUERY_CHUNK
    W = NSA_WINDOW
    LS = NSA_SLC_BLOCK
    qh = q.reshape(B, S, G, HPG, dh).transpose(0, 2, 3, 1, 4) * (dh ** -0.5)
    gh = gates.reshape(B, S, G, HPG, 3).transpose(0, 2, 3, 1, 4)
    rb = rel_bias.reshape(N_BUCKETS, G, HPG)
    k_cmp = _compress(kc, cmp_pos, w1k, w2k)
    v_cmp = _compress(vc, cmp_pos, w1v, w2v)
    n_cmp = k_cmp.shape[2]
    cmp_start = jnp.arange(n_cmp) * NSA_CMP_STRIDE
    cmp_end = cmp_start + NSA_CMP_LEN - 1
    n_slc = S // LS
    n_top = min(NSA_SLC_TOPN, n_slc)
    slc_start = jnp.arange(n_slc) * LS
    overlap = jnp.maximum(jnp.minimum(cmp_start[:, None] + NSA_CMP_LEN, slc_start[None, :] + LS)
                          - jnp.maximum(cmp_start[:, None], slc_start[None, :]), 0).astype(jnp.float32) / NSA_CMP_LEN
    k_slc = ks.transpose(0, 2, 1, 3).reshape(B, G, n_slc, LS, dh)
    v_slc = vs.transpose(0, 2, 1, 3).reshape(B, G, n_slc, LS, dh)
    wpad = ((0, 0), (0, 0), (W, 0), (0, 0))
    k_win = jnp.pad(kw.transpose(0, 2, 1, 3), wpad)
    v_win = jnp.pad(vw.transpose(0, 2, 1, 3), wpad)
    b_ix = jnp.arange(B)[:, None, None, None]
    g_ix = jnp.arange(G)[None, :, None, None]
    blk = jnp.arange(n_slc)
    offs = jnp.arange(LS)

    def chunk(q0):
        qc = lax.dynamic_slice_in_dim(qh, q0, QC, axis=3)
        gc = lax.dynamic_slice_in_dim(gh, q0, QC, axis=3)
        t = q0 + jnp.arange(QC)
        s_c = jnp.einsum('bghqd,bgnd->bghqn', qc, k_cmp) + rb[t5_bucket(t[:, None] - cmp_end[None, :])].transpose(2, 3, 0, 1)
        p_c = masked_softmax(s_c, cmp_end[None, :] <= t[:, None])
        o_c = jnp.einsum('bghqn,bgnd->bghqd', p_c.astype(qc.dtype), v_cmp)
        imp = jnp.einsum('bghqn,nm->bgqm', p_c, overlap)
        tb = (t // LS)[:, None]
        forced = (blk == 0) | (blk == tb) | (blk == tb - 1)
        imp = jnp.where(blk > tb, -jnp.inf, jnp.where(forced, jnp.inf, imp))
        _, sel = lax.top_k(imp, n_top)
        k_sel = k_slc[b_ix, g_ix, sel].reshape(B, G, QC, n_top * LS, dh)
        v_sel = v_slc[b_ix, g_ix, sel].reshape(B, G, QC, n_top * LS, dh)
        pos = (sel[..., None] * LS + offs).reshape(B, G, QC, n_top * LS)
        bias_s = rb[t5_bucket(t[:, None] - pos), g_ix].transpose(0, 1, 4, 2, 3)
        s_s = jnp.einsum('bghqd,bgqkd->bghqk', qc, k_sel) + bias_s
        p_s = masked_softmax(s_s, (pos <= t[:, None])[:, :, None])
        o_s = jnp.einsum('bghqk,bgqkd->bghqd', p_s.astype(qc.dtype), v_sel)
        kwc = lax.dynamic_slice_in_dim(k_win, q0, W + QC, axis=2)
        vwc = lax.dynamic_slice_in_dim(v_win, q0, W + QC, axis=2)
        pos_w = q0 - W + jnp.arange(W + QC)
        dist = t[:, None] - pos_w[None, :]
        s_w = jnp.einsum('bghqd,bgkd->bghqk', qc, kwc) + rb[t5_bucket(dist)].transpose(2, 3, 0, 1)
        p_w = masked_softmax(s_w, (dist >= 0) & (dist < W) & (pos_w[None, :] >= 0))
        o_w = jnp.einsum('bghqk,bgkd->bghqd', p_w.astype(qc.dtype), vwc)
        o = gc[..., 0:1] * o_c + gc[..., 1:2] * o_s + gc[..., 2:3] * o_w
        return o.astype(q.dtype)

    out = lax.map(chunk, jnp.arange(0, S, QC))
    return out.transpose(1, 0, 4, 2, 3, 5).reshape(B, S, H * dh)


def mixer_nsa(h, w_in, cmp_pos, w1k, w2k, w1v, w2v, w_out, rel_bias):
    B, S, _ = h.shape
    q, kc, vc, ks, vs, kw, vw, g = _split(h @ w_in, NSA_IN_SIZES)
    kvs = lambda a: a.reshape(B, S, NSA_KV_GROUPS, NSA_HEAD_DIM)
    gates = jax.nn.sigmoid(g.astype(jnp.float32)).reshape(B, S, NSA_HEADS, 3)
    y = nsa_attention(q.reshape(B, S, NSA_HEADS, NSA_HEAD_DIM), kvs(kc), kvs(vc), kvs(ks), kvs(vs), kvs(kw), kvs(vw),
                      gates, rel_bias, cmp_pos, w1k, w2k, w1v, w2v)
    return y @ w_out


def swiglu(x, w1, w3, w2):
    return (jax.nn.silu(x @ w1) * (x @ w3)) @ w2


def moe_swiglu(h, w_router, w1, w3, w2):
    B, S, D = h.shape
    n_tok = B * S
    n_assign = n_tok * TOP_K
    n_blocks = (n_assign + N_EXPERTS * (MOE_ROW_BLOCK - 1) + MOE_ROW_BLOCK - 1) // MOE_ROW_BLOCK
    x = h.reshape(n_tok, D)
    logits = (x @ w_router).astype(jnp.float32)
    top_logit, top_e = lax.top_k(logits, TOP_K)
    top_w = jax.nn.softmax(top_logit, axis=-1)
    flat_e = top_e.reshape(-1)
    flat_tok = jnp.repeat(jnp.arange(n_tok), TOP_K)
    flat_w = top_w.reshape(-1)
    order = jnp.argsort(flat_e)
    se, st, sw = flat_e[order], flat_tok[order], flat_w[order]
    counts = jnp.bincount(flat_e, length=N_EXPERTS)
    starts = jnp.cumsum(counts) - counts
    padded = (counts + MOE_ROW_BLOCK - 1) // MOE_ROW_BLOCK * MOE_ROW_BLOCK
    pad_end = jnp.cumsum(padded)
    pad_start = pad_end - padded
    dest = pad_start[se] + jnp.arange(n_assign) - starts[se]
    n_rows = n_blocks * MOE_ROW_BLOCK
    row_tok = jnp.zeros((n_rows,), jnp.int32).at[dest].set(st)
    row_w = jnp.zeros((n_rows,), jnp.float32).at[dest].set(sw)
    blk_e = jnp.minimum(jnp.searchsorted(pad_end, jnp.arange(n_blocks) * MOE_ROW_BLOCK, side='right'), N_EXPERTS - 1)

    def run(args):
        tok, wgt, e = args
        y = swiglu(x[tok], w1[e], w3[e], w2[e])
        return y * wgt[:, None].astype(y.dtype)

    ys = lax.map(run, (row_tok.reshape(n_blocks, MOE_ROW_BLOCK), row_w.reshape(n_blocks, MOE_ROW_BLOCK), blk_e))
    out = jnp.zeros_like(x).at[row_tok].add(ys.reshape(n_rows, D))
    return out.reshape(B, S, D)


def setup_inputs(seed: int = 0) -> dict:
    key = jax.random.key(seed)
    keys = iter(jax.random.split(key, 32))
    D = D_MODEL

    def nrm(shape, scale):
        return jax.random.normal(next(keys), shape, jnp.float32) * scale

    cmp_in = NSA_CMP_LEN * NSA_HEAD_DIM
    return {
        "x": nrm((BATCH, SEQ, D), 1.0),
        "c": nrm((BATCH, D), 1.0),
        "rel_bias": nrm((N_BUCKETS, N_ATT_HEADS), 0.2),
        "ada_w": nrm((DEPTH, D, 6 * D), 0.2 * D ** -0.5),
        "ada_b": nrm((DEPTH, 6 * D), 0.01),
        "ln_g": 1.0 + nrm((DEPTH, 2, D), 0.02),
        "ln_b": nrm((DEPTH, 2, D), 0.02),
        "ab_w_in": nrm((N_EVEN, D, AB_IN_WIDTH), D ** -0.5),
        "gla_wg2": nrm((N_EVEN, GLA_GATE_RANK, GLA_QK_WIDTH), GLA_GATE_RANK ** -0.5),
        "gla_bg2": nrm((N_EVEN, GLA_QK_WIDTH), 0.1),
        "gla_norm_g": 1.0 + nrm((N_EVEN, GLA_V_WIDTH), 0.02),
        "ab_w_out": nrm((N_EVEN, AB_OUT_WIDTH, D), BETA_DN * AB_OUT_WIDTH ** -0.5),
        "ffn_w1": nrm((N_EVEN, D, D_FF), D ** -0.5),
        "ffn_w3": nrm((N_EVEN, D, D_FF), D ** -0.5),
        "ffn_w2": nrm((N_EVEN, D_FF, D), BETA_DN * D_FF ** -0.5),
        "nsa_w_in": nrm((N_ODD, D, NSA_IN_WIDTH), D ** -0.5),
        "nsa_cmp_pos": nrm((N_ODD, NSA_CMP_LEN, NSA_HEAD_DIM), 0.02),
        "nsa_cmp_w1k": nrm((N_ODD, cmp_in, NSA_HEAD_DIM), cmp_in ** -0.5),
        "nsa_cmp_w2k": nrm((N_ODD, NSA_HEAD_DIM, NSA_HEAD_DIM), NSA_HEAD_DIM ** -0.5),
        "nsa_cmp_w1v": nrm((N_ODD, cmp_in, NSA_HEAD_DIM), cmp_in ** -0.5),
        "nsa_cmp_w2v": nrm((N_ODD, NSA_HEAD_DIM, NSA_HEAD_DIM), NSA_HEAD_DIM ** -0.5),
        "nsa_w_out": nrm((N_ODD, NSA_Q_WIDTH, D), BETA_DN * NSA_Q_WIDTH ** -0.5),
        "moe_router": nrm((N_ODD, D, N_EXPERTS), D ** -0.5),
        "moe_w1": nrm((N_ODD, N_EXPERTS, D, D_FF_EXPERT), D ** -0.5),
        "moe_w3": nrm((N_ODD, N_EXPERTS, D, D_FF_EXPERT), D ** -0.5),
        "moe_w2": nrm((N_ODD, N_EXPERTS, D_FF_EXPERT, D), BETA_DN * D_FF_EXPERT ** -0.5),
    }


def reference(x, c, rel_bias, ada_w, ada_b, ln_g, ln_b, ab_w_in, gla_wg2, gla_bg2, gla_norm_g, ab_w_out,
              ffn_w1, ffn_w3, ffn_w2, nsa_w_in, nsa_cmp_pos, nsa_cmp_w1k, nsa_cmp_w2k, nsa_cmp_w1v, nsa_cmp_w2v,
              nsa_w_out, moe_router, moe_w1, moe_w3, moe_w2):
    cond = jax.nn.silu(c)
    for i in range(DEPTH):
        j = i // 2
        mod = (cond @ ada_w[i] + ada_b[i])[:, None, :]
        sh1, sc1, g1, sh2, sc2, g2 = jnp.split(mod, 6, axis=-1)
        h = x * (1 + sc1) + sh1
        if i % 2 == 0:
            y = mixer_moba_gla(h, ab_w_in[j], gla_wg2[j], gla_bg2[j], gla_norm_g[j], ab_w_out[j], rel_bias)
        else:
            y = mixer_nsa(h, nsa_w_in[j], nsa_cmp_pos[j], nsa_cmp_w1k[j], nsa_cmp_w2k[j], nsa_cmp_w1v[j],
                          nsa_cmp_w2v[j], nsa_w_out[j], rel_bias)
        x = layer_norm(ALPHA_DN * x + (1 + g1) * y, ln_g[i, 0], ln_b[i, 0])
        h = x * (1 + sc2) + sh2
        if i % 2 == 0:
            y = swiglu(h, ffn_w1[j], ffn_w3[j], ffn_w2[j])
        else:
            y = moe_swiglu(h, moe_router[j], moe_w1[j], moe_w3[j], moe_w2[j])
        x = layer_norm(ALPHA_DN * x + (1 + g2) * y, ln_g[i, 1], ln_b[i, 1])
    return x
```

```cpp
#include <hip/hip_runtime.h>
#include <stdint.h>
#include <stdio.h>
typedef _Float16 f16;
typedef _Float16 f16x8 __attribute__((ext_vector_type(8)));
typedef float f32x4 __attribute__((ext_vector_type(4)));

constexpr int NB = 4, SEQ = 4096, DM = 1024, NT = NB * SEQ, DEPTH = 4;
constexpr int ABW = 3088, ABP = 3072;
constexpr int NSW = 2584, NSP = 2560;
constexpr int DFF = 2816, DFE = 3584, NEXP = 8;
constexpr int MOE_ROWS = 2 * NT + NEXP * 256;
constexpr int MOE_T256 = MOE_ROWS / 256;
constexpr float ALPHA_DN = 1.681792830507429f;
constexpr float LN_EPS = 1e-5f, RMS_EPS = 1e-6f;

constexpr size_t MiB = 1u << 20;
constexpr size_t WS_CTL = 0;
constexpr size_t CTL_BYTES = 1 * MiB;
constexpr size_t WS_MOD = 1 * MiB;
constexpr size_t WS_BIAS = 2 * MiB;
constexpr size_t WS_KMEAN = 3 * MiB;
constexpr size_t WS_KCMP = 4 * MiB;
constexpr size_t WS_VCMP = 5 * MiB;
constexpr size_t WS_MOEI = 6 * MiB;
constexpr size_t WS_GLR = 8 * MiB;
constexpr size_t WS_GATES = 9 * MiB;
constexpr size_t WS_H = 16 * MiB;
constexpr size_t WS_PROJ = 48 * MiB;
constexpr size_t WS_LA = 144 * MiB;
constexpr size_t WS_GLAO = 160 * MiB;
constexpr size_t WS_YCAT = 192 * MiB;
constexpr size_t WS_Y = 224 * MiB;
constexpr size_t WS_FFI = 288 * MiB;
constexpr size_t WS_INTER = 376 * MiB;
constexpr size_t WS_YA = 616 * MiB;
constexpr size_t WS_END = 752 * MiB;
constexpr int CW_CNT = 0;
constexpr int CW_OFF = 16;
constexpr int CW_TEXP = 64;
constexpr int CW_ROWTOK = 1024;
constexpr int CW_ROWW = 1024 + 36864;

__device__ __forceinline__ float wave_sum(float v) { for (int o = 32; o > 0; o >>= 1) v += __shfl_xor(v, o); return v; }
__device__ __forceinline__ float wave_max(float v) { for (int o = 32; o > 0; o >>= 1) v = fmaxf(v, __shfl_xor(v, o)); return v; }
__device__ __forceinline__ float silu_f(float x) { return x / (1.f + expf(-x)); }
__device__ __forceinline__ int t5_bucket(int n) {
    if (n < 16) return n < 0 ? 0 : n;
    return 16 + (n >= 21) + (n >= 27) + (n >= 35) + (n >= 46) + (n >= 59) + (n >= 77) + (n >= 99) + (n >= 128) + (n >= 166) + (n >= 216) + (n >= 280) + (n >= 363) + (n >= 470) + (n >= 609) + (n >= 790);
}

__global__ void __launch_bounds__(256) k_mod(const float* __restrict__ c, const float* __restrict__ ada_w, const float* __restrict__ ada_b, float* __restrict__ mod) {
    __shared__ float cond[4][1024];
    const int i = blockIdx.x / 24, n = (blockIdx.x % 24) * 256 + threadIdx.x;
    for (int idx = threadIdx.x; idx < 4096; idx += 256) { const float v = c[idx]; cond[idx >> 10][idx & 1023] = v / (1.f + expf(-v)); }
    __syncthreads();
    float a0 = 0.f, a1 = 0.f, a2 = 0.f, a3 = 0.f;
    const float* w = ada_w + (size_t)i * 1024 * 6144 + n;
#pragma unroll 8
    for (int k = 0; k < 1024; ++k) { const float wv = w[(size_t)k * 6144]; a0 += cond[0][k] * wv; a1 += cond[1][k] * wv; a2 += cond[2][k] * wv; a3 += cond[3][k] * wv; }
    const float bb = ada_b[i * 6144 + n];
    mod[(i * 4 + 0) * 6144 + n] = a0 + bb; mod[(i * 4 + 1) * 6144 + n] = a1 + bb; mod[(i * 4 + 2) * 6144 + n] = a2 + bb; mod[(i * 4 + 3) * 6144 + n] = a3 + bb;
}
__global__ void k_bias(const float* __restrict__ rel_bias, float* __restrict__ biasT) {
    const int idx = blockIdx.x * 256 + threadIdx.x;
    const int h = idx >> 12, dist = idx & 4095;
    biasT[idx] = rel_bias[t5_bucket(dist) * 8 + h];
}
__global__ void k_modulate(const float* __restrict__ x, const float* __restrict__ modl, int sh_off, int sc_off, f16* __restrict__ H) {
    const size_t idx = (size_t)blockIdx.x * 256 + threadIdx.x;
    const int m = (int)(idx >> 10), d = (int)(idx & 1023), b = m >> 12;
    H[idx] = (f16)(x[idx] * (1.f + modl[b * 6144 + sc_off + d]) + modl[b * 6144 + sh_off + d]);
}

struct GemmP {
    const f16* A; int lda; const int* rowidx;
    const float* W; const float* W3; int ldw;
    int M, N, K, mode;
    f16* C16; int ldc16; int nsplit; float* C32; int ldc32; const float* roww;
    const int* texp; size_t wstride;
};
template <bool DUAL>
__global__ void __launch_bounds__(256) k_gemm(GemmP p) {
    __shared__ float As[16][132];
    __shared__ float Bs[16][64];
    __shared__ float B3s[DUAL ? 16 : 1][64];
    const int tid = threadIdx.x, tx = tid & 15, ty = tid >> 4;
    const int m0 = blockIdx.y * 128, n0 = blockIdx.x * 64;
    const float* W = p.W; const float* W3 = p.W3;
    if (p.texp) { const int e = p.texp[m0 >> 8] - 1; if (e < 0) return; W += (size_t)e * p.wstride; if (DUAL) W3 += (size_t)e * p.wstride; }
    float acc[8][4], acc3[DUAL ? 8 : 1][4];
#pragma unroll
    for (int i = 0; i < 8; ++i)
#pragma unroll
        for (int j = 0; j < 4; ++j) { acc[i][j] = 0.f; if constexpr (DUAL) acc3[i][j] = 0.f; }
    const int ar = tid >> 1, ak = (tid & 1) * 8;
    const int arow = p.rowidx ? p.rowidx[m0 + ar] : (m0 + ar);
    const f16* Ap = p.A + (size_t)arow * p.lda + ak;
    const int bk = tid >> 4, bn = (tid & 15) * 4;
    const bool bok = (n0 + bn) < p.N;
    for (int k0 = 0; k0 < p.K; k0 += 16) {
        const f16x8 av = *(const f16x8*)(Ap + k0);
        f32x4 bv = (f32x4){0.f, 0.f, 0.f, 0.f}, b3v = (f32x4){0.f, 0.f, 0.f, 0.f};
        if (bok) { bv = *(const f32x4*)(W + (size_t)(k0 + bk) * p.ldw + n0 + bn); if constexpr (DUAL) b3v = *(const f32x4*)(W3 + (size_t)(k0 + bk) * p.ldw + n0 + bn); }
        __syncthreads();
#pragma unroll
        for (int j = 0; j < 8; ++j) As[ak + j][ar] = (float)av[j];
        *(f32x4*)&Bs[bk][bn] = bv;
        if constexpr (DUAL) *(f32x4*)&B3s[bk][bn] = b3v;
        __syncthreads();
#pragma unroll
        for (int k = 0; k < 16; ++k) {
            const f32x4 a0 = *(const f32x4*)&As[k][ty * 8], a1 = *(const f32x4*)&As[k][ty * 8 + 4];
            const f32x4 b = *(const f32x4*)&Bs[k][tx * 4];
            const float a[8] = {a0[0], a0[1], a0[2], a0[3], a1[0], a1[1], a1[2], a1[3]};
#pragma unroll
            for (int i = 0; i < 8; ++i)
#pragma unroll
                for (int j = 0; j < 4; ++j) acc[i][j] += a[i] * b[j];
            if constexpr (DUAL) { const f32x4 b3 = *(const f32x4*)&B3s[k][tx * 4];
#pragma unroll
                for (int i = 0; i < 8; ++i)
#pragma unroll
                    for (int j = 0; j < 4; ++j) acc3[i][j] += a[i] * b3[j]; }
        }
    }
    const int col = n0 + tx * 4;
    if (col >= p.N) return;
#pragma unroll
    for (int i = 0; i < 8; ++i) {
        const int row = m0 + ty * 8 + i;
        if (p.mode == 0) {
            if (col < p.nsplit) {
#pragma unroll
                for (int j = 0; j < 4; ++j) p.C16[(size_t)row * p.ldc16 + col + j] = (f16)acc[i][j];
            } else {
#pragma unroll
                for (int j = 0; j < 4; ++j) p.C32[(size_t)row * p.ldc32 + (col - p.nsplit) + j] = acc[i][j];
            }
        } else if (p.mode == 1) {
#pragma unroll
            for (int j = 0; j < 4; ++j) p.C32[(size_t)row * p.ldc32 + col + j] = acc[i][j];
        } else if (p.mode == 2) {
            if constexpr (DUAL) {
#pragma unroll
                for (int j = 0; j < 4; ++j) p.C16[(size_t)row * p.ldc16 + col + j] = (f16)(silu_f(acc[i][j]) * acc3[i][j]);
            }
        } else {
            const float w = p.roww[row];
#pragma unroll
            for (int j = 0; j < 4; ++j) p.C32[(size_t)row * p.ldc32 + col + j] = acc[i][j] * w;
        }
    }
}

__global__ void k_gla_gate(const float* __restrict__ glr, const float* __restrict__ wg2, const float* __restrict__ bg2, float* __restrict__ LA) {
    const size_t idx = (size_t)blockIdx.x * 256 + threadIdx.x;
    const int m = (int)(idx >> 8), cc = (int)(idx & 255);
    float z = bg2[cc];
#pragma unroll
    for (int r = 0; r < 16; ++r) z += glr[m * 16 + r] * wg2[r * 256 + cc];
    const float ls = fminf(z, 0.f) - log1pf(expf(-fabsf(z)));
    LA[idx] = ls * (1.f / 16.f);
}
__global__ void k_kmean(const f16* __restrict__ proj, float* __restrict__ kmean) {
    const int blk = blockIdx.x;
    const int n = blk & 15, h = (blk >> 4) & 7, b = blk >> 7, d = threadIdx.x;
    float s = 0.f;
    for (int r = 0; r < 256; ++r) s += (float)proj[(size_t)(b * SEQ + n * 256 + r) * ABP + 512 + h * 64 + d];
    kmean[blk * 64 + d] = s * (1.f / 256.f);
}
__global__ void __launch_bounds__(256) k_moba(const f16* __restrict__ proj, const float* __restrict__ kmean, const float* __restrict__ biasT, f16* __restrict__ ycat) {
    __shared__ float qs[4][64];
    __shared__ float pl[4][1024];
    const int wv = threadIdx.x >> 6, lane = threadIdx.x & 63;
    const int gw = blockIdx.x * 4 + wv;
    const int t = gw & 4095, h = (gw >> 12) & 7, b = gw >> 15;
    const int m = b * SEQ + t, qb = t >> 8;
    const float q = (float)proj[(size_t)m * ABP + h * 64 + lane] * 0.125f;
    qs[wv][lane] = q;
    float g0 = -INFINITY, g1 = -INFINITY, g2 = -INFINITY; int i0 = -1, i1 = -1, i2 = -1;
    for (int n = 0; n < qb; ++n) {
        const float g = wave_sum(q * kmean[((b * 8 + h) * 16 + n) * 64 + lane]);
        if (g > g0) { g2 = g1; i2 = i1; g1 = g0; i1 = i0; g0 = g; i0 = n; }
        else if (g > g1) { g2 = g1; i2 = i1; g1 = g; i1 = n; }
        else if (g > g2) { g2 = g; i2 = n; }
    }
    __syncthreads();
    const float* bt = biasT + h * 4096;
    float sc[4][4]; float mx = -INFINITY;
#pragma unroll
    for (int bi = 0; bi < 4; ++bi) {
        const int blk = bi == 0 ? i0 : (bi == 1 ? i1 : (bi == 2 ? i2 : qb));
#pragma unroll
        for (int kk = 0; kk < 4; ++kk) {
            float s = -INFINITY;
            if (blk >= 0) {
                const int pos = blk * 256 + kk * 64 + lane;
                if (pos <= t) {
                    const f16* kr = proj + (size_t)(b * SEQ + pos) * ABP + 512 + h * 64;
                    float a = 0.f;
#pragma unroll
                    for (int d8 = 0; d8 < 8; ++d8) { const f16x8 kv = *(const f16x8*)(kr + d8 * 8);
#pragma unroll
                        for (int j = 0; j < 8; ++j) a += qs[wv][d8 * 8 + j] * (float)kv[j]; }
                    s = a + bt[t - pos];
                }
            }
            sc[bi][kk] = s; mx = fmaxf(mx, s);
        }
    }
    mx = wave_max(mx);
    float sum = 0.f;
#pragma unroll
    for (int bi = 0; bi < 4; ++bi)
#pragma unroll
        for (int kk = 0; kk < 4; ++kk) { const float pp = (sc[bi][kk] == -INFINITY) ? 0.f : expf(sc[bi][kk] - mx); sc[bi][kk] = pp; sum += pp; }
    sum = wave_sum(sum);
    const float inv = 1.f / sum;
#pragma unroll
    for (int bi = 0; bi < 4; ++bi)
#pragma unroll
        for (int kk = 0; kk < 4; ++kk) pl[wv][bi * 256 + kk * 64 + lane] = sc[bi][kk] * inv;
    __syncthreads();
    float o = 0.f;
    for (int bi = 0; bi < 4; ++bi) {
        const int blk = bi == 0 ? i0 : (bi == 1 ? i1 : (bi == 2 ? i2 : qb));
        if (blk < 0) continue;
        const int nk = (bi == 3) ? (t - qb * 256 + 1) : 256;
        const f16* vr = proj + (size_t)(b * SEQ + blk * 256) * ABP + 1024 + h * 64 + lane;
        for (int r = 0; r < nk; ++r) o += pl[wv][bi * 256 + r] * (float)vr[(size_t)r * ABP];
    }
    ycat[(size_t)m * 1024 + h * 64 + lane] = (f16)o;
}
__global__ void __launch_bounds__(64) k_gla(const f16* __restrict__ proj, const float* __restrict__ LA, float* __restrict__ glao) {
    const int js = blockIdx.x & 15, h = (blockIdx.x >> 4) & 3, b = blockIdx.x >> 6, lane = threadIdx.x;
    float S[8];
#pragma unroll
    for (int j = 0; j < 8; ++j) S[j] = 0.f;
#pragma unroll 4
    for (int t = 0; t < SEQ; ++t) {
        const size_t m = (size_t)b * SEQ + t;
        const float qi = (float)proj[m * ABP + 1536 + h * 64 + lane] * 0.125f;
        const float ki = (float)proj[m * ABP + 1792 + h * 64 + lane];
        const float a = expf(LA[m * 256 + h * 64 + lane]);
        const f16x8 vv = *(const f16x8*)(proj + m * ABP + 2048 + h * 128 + js * 8);
        float o[8];
#pragma unroll
        for (int j = 0; j < 8; ++j) { S[j] = a * S[j] + ki * (float)vv[j]; o[j] = qi * S[j]; }
#pragma unroll
        for (int j = 0; j < 8; ++j) o[j] = wave_sum(o[j]);
        if (lane == 0) {
#pragma unroll
            for (int j = 0; j < 8; ++j) glao[m * 512 + h * 128 + js * 8 + j] = o[j];
        }
    }
}
__global__ void __launch_bounds__(256) k_gla_norm(const float* __restrict__ glao, const f16* __restrict__ proj, const float* __restrict__ norm_g, f16* __restrict__ ycat) {
    const int wv = threadIdx.x >> 6, lane = threadIdx.x & 63;
    const int gw = blockIdx.x * 4 + wv;
    const int h = gw & 3; const size_t m = gw >> 2;
    const float o0 = glao[m * 512 + h * 128 + lane], o1 = glao[m * 512 + h * 128 + 64 + lane];
    const float ms = wave_sum(o0 * o0 + o1 * o1) * (1.f / 128.f);
    const float r = rsqrtf(ms + RMS_EPS);
    const float g0 = (float)proj[m * ABP + 2560 + h * 128 + lane], g1 = (float)proj[m * ABP + 2560 + h * 128 + 64 + lane];
    ycat[m * 1024 + 512 + h * 128 + lane] = (f16)(o0 * r * norm_g[h * 128 + lane] * silu_f(g0));
    ycat[m * 1024 + 512 + h * 128 + 64 + lane] = (f16)(o1 * r * norm_g[h * 128 + 64 + lane] * silu_f(g1));
}

__global__ void __launch_bounds__(256) k_ln(const float* __restrict__ xin, float* __restrict__ xout, const float* __restrict__ y, const float* __restrict__ ya, const int* __restrict__ slot,
                                            const float* __restrict__ modl, int g_off, const float* __restrict__ lng, const float* __restrict__ lnb,
                                            const float* __restrict__ modn, int sh_off, int sc_off, f16* __restrict__ H) {
    const int wv = threadIdx.x >> 6, lane = threadIdx.x & 63;
    const size_t m = (size_t)blockIdx.x * 4 + wv; const int b = (int)(m >> 12);
    float v[16]; float s = 0.f;
    const float* y0 = y ? y + m * 1024 : ya + (size_t)slot[m * 2] * 1024;
    const float* y1 = y ? nullptr : ya + (size_t)slot[m * 2 + 1] * 1024;
#pragma unroll
    for (int j = 0; j < 4; ++j) {
        const int d = j * 256 + lane * 4;
        const f32x4 xv = *(const f32x4*)(xin + m * 1024 + d);
        f32x4 yv = *(const f32x4*)(y0 + d);
        if (y1) yv += *(const f32x4*)(y1 + d);
        const f32x4 gv = *(const f32x4*)(modl + b * 6144 + g_off + d);
#pragma unroll
        for (int e = 0; e < 4; ++e) { v[j * 4 + e] = ALPHA_DN * xv[e] + (1.f + gv[e]) * yv[e]; s += v[j * 4 + e]; }
    }
    const float mean = wave_sum(s) * (1.f / 1024.f);
    float s2 = 0.f;
#pragma unroll
    for (int i = 0; i < 16; ++i) { v[i] -= mean; s2 += v[i] * v[i]; }
    const float rstd = rsqrtf(wave_sum(s2) * (1.f / 1024.f) + LN_EPS);
#pragma unroll
    for (int j = 0; j < 4; ++j) {
        const int d = j * 256 + lane * 4;
        const f32x4 gg = *(const f32x4*)(lng + d), bb = *(const f32x4*)(lnb + d);
        f32x4 o;
#pragma unroll
        for (int e = 0; e < 4; ++e) o[e] = v[j * 4 + e] * rstd * gg[e] + bb[e];
        *(f32x4*)(xout + m * 1024 + d) = o;
        if (H) {
            const f32x4 sc = *(const f32x4*)(modn + b * 6144 + sc_off + d), sh = *(const f32x4*)(modn + b * 6144 + sh_off + d);
#pragma unroll
            for (int e = 0; e < 4; ++e) H[m * 1024 + d + e] = (f16)(o[e] * (1.f + sc[e]) + sh[e]);
        }
    }
}

__global__ void k_sigmoid(float* __restrict__ g, int n) { const int i = blockIdx.x * 256 + threadIdx.x; if (i < n) g[i] = 1.f / (1.f + expf(-g[i])); }
__global__ void __launch_bounds__(128) k_compress(const f16* __restrict__ proj, const float* __restrict__ pos, const float* __restrict__ w1k, const float* __restrict__ w2k,
                                                  const float* __restrict__ w1v, const float* __restrict__ w2v, f16* __restrict__ kcmp, f16* __restrict__ vcmp) {
    __shared__ float xs[2][4096];
    __shared__ float hs[2][128];
    const int ng = blockIdx.x & 127, g = (blockIdx.x >> 7) & 1, b = (blockIdx.x >> 8) & 3, which = blockIdx.x >> 10;
    const float* w1 = which ? w1v : w1k; const float* w2 = which ? w2v : w2k;
    const int colbase = (which ? 1280 : 1024) + g * 128;
    const int c = threadIdx.x;
    for (int nn = 0; nn < 2; ++nn) {
        const int n = ng * 2 + nn;
        for (int idx = c; idx < 4096; idx += 128) {
            const int l = idx >> 7, d = idx & 127;
            float v = 0.f;
            if (n < 255) v = (float)proj[(size_t)(b * SEQ + n * 16 + l) * NSP + colbase + d] + pos[l * 128 + d];
            xs[nn][idx] = v;
        }
    }
    __syncthreads();
    float a0 = 0.f, a1 = 0.f;
#pragma unroll 4
    for (int k = 0; k < 4096; ++k) { const float w = w1[(size_t)k * 128 + c]; a0 += xs[0][k] * w; a1 += xs[1][k] * w; }
    hs[0][c] = silu_f(a0); hs[1][c] = silu_f(a1);
    __syncthreads();
    float o0 = 0.f, o1 = 0.f;
    for (int k = 0; k < 128; ++k) { const float w = w2[k * 128 + c]; o0 += hs[0][k] * w; o1 += hs[1][k] * w; }
    f16* out = (which ? vcmp : kcmp) + ((size_t)(b * 2 + g) * 256 + ng * 2) * 128 + c;
    out[0] = (f16)o0; out[128] = (f16)o1;
}
__device__ __forceinline__ void dot4(const float (*qs)[128], const f16* kr, float& s0, float& s1, float& s2, float& s3) {
    s0 = s1 = s2 = s3 = 0.f;
#pragma unroll 4
    for (int d8 = 0; d8 < 16; ++d8) {
        const f16x8 kv = *(const f16x8*)(kr + d8 * 8);
#pragma unroll
        for (int j = 0; j < 8; ++j) { const float k = (float)kv[j]; const int d = d8 * 8 + j; s0 += qs[0][d] * k; s1 += qs[1][d] * k; s2 += qs[2][d] * k; s3 += qs[3][d] * k; }
    }
}
__global__ void __launch_bounds__(128) k_nsa(const f16* __restrict__ proj, const float* __restrict__ gates, const f16* __restrict__ kcmp, const f16* __restrict__ vcmp,
                                             const float* __restrict__ biasT, f16* __restrict__ yout) {
    __shared__ float qsm[2][4][128];
    __shared__ float psm[2][4][1024];
    const int wv = threadIdx.x >> 6, lane = threadIdx.x & 63;
    const int gw = blockIdx.x * 2 + wv;
    const int t = gw & 4095, g = (gw >> 12) & 1, b = gw >> 13;
    const size_t m = (size_t)b * SEQ + t;
    float (*qs)[128] = qsm[wv]; float (*ps)[1024] = psm[wv];
    const float qscale = 0.08838834764831845f;
#pragma unroll
    for (int hh = 0; hh < 4; ++hh) { qs[hh][lane] = (float)proj[m * NSP + (g * 4 + hh) * 128 + lane] * qscale; qs[hh][lane + 64] = (float)proj[m * NSP + (g * 4 + hh) * 128 + 64 + lane] * qscale; }
    __syncthreads();
    const float* bt0 = biasT + (g * 4) * 4096;
    float oacc[4][2];
    float ofin[4][2];
#pragma unroll
    for (int hh = 0; hh < 4; ++hh) { ofin[hh][0] = 0.f; ofin[hh][1] = 0.f; }
    const float* gt = gates + m * 24 + g * 12;
    {
        float sc[4][4]; float mx[4] = {-INFINITY, -INFINITY, -INFINITY, -INFINITY};
#pragma unroll
        for (int i = 0; i < 4; ++i) {
            const int n = i * 64 + lane; const int cend = n * 16 + 31;
            float s0 = -INFINITY, s1 = -INFINITY, s2 = -INFINITY, s3 = -INFINITY;
            if (n < 255 && cend <= t) {
                dot4(qs, kcmp + ((size_t)(b * 2 + g) * 256 + n) * 128, s0, s1, s2, s3);
                const int dist = t - cend;
                s0 += bt0[dist]; s1 += bt0[4096 + dist]; s2 += bt0[8192 + dist]; s3 += bt0[12288 + dist];
            }
            sc[0][i] = s0; sc[1][i] = s1; sc[2][i] = s2; sc[3][i] = s3;
            mx[0] = fmaxf(mx[0], s0); mx[1] = fmaxf(mx[1], s1); mx[2] = fmaxf(mx[2], s2); mx[3] = fmaxf(mx[3], s3);
        }
#pragma unroll
        for (int hh = 0; hh < 4; ++hh) {
            const float mm = wave_max(mx[hh]);
            float sum = 0.f;
#pragma unroll
            for (int i = 0; i < 4; ++i) { const float pp = (sc[hh][i] == -INFINITY) ? 0.f : expf(sc[hh][i] - mm); sc[hh][i] = pp; sum += pp; }
            sum = wave_sum(sum);
            const float inv = sum > 0.f ? 1.f / sum : 0.f;
#pragma unroll
            for (int i = 0; i < 4; ++i) ps[hh][i * 64 + lane] = sc[hh][i] * inv;
        }
        __syncthreads();
        const int nvis = (t >= 31) ? min(255, (t - 31) / 16 + 1) : 0;
#pragma unroll
        for (int hh = 0; hh < 4; ++hh) { oacc[hh][0] = 0.f; oacc[hh][1] = 0.f; }
        const f16* vb = vcmp + (size_t)(b * 2 + g) * 256 * 128 + 2 * lane;
        for (int n = 0; n < nvis; ++n) {
            const float v0 = (float)vb[n * 128], v1 = (float)vb[n * 128 + 1];
#pragma unroll
            for (int hh = 0; hh < 4; ++hh) { const float pp = ps[hh][n]; oacc[hh][0] += pp * v0; oacc[hh][1] += pp * v1; }
        }
#pragma unroll
        for (int hh = 0; hh < 4; ++hh) { const float gg = gt[hh * 3 + 0]; ofin[hh][0] += gg * oacc[hh][0]; ofin[hh][1] += gg * oacc[hh][1]; }
    }
    unsigned long long selmask;
    {
        const int mb = lane, tb = t >> 6;
        float imp = 0.f;
#pragma unroll
        for (int hh = 0; hh < 4; ++hh) {
            float a = ps[hh][4 * mb] + ps[hh][4 * mb + 1] + ps[hh][4 * mb + 2];
            if (4 * mb + 3 < 255) a += 0.5f * ps[hh][4 * mb + 3];
            if (mb > 0) a += 0.5f * ps[hh][4 * mb - 1];
            imp += a;
        }
        const bool forced = (mb == 0) || (mb == tb) || (mb == tb - 1);
        float v = (mb > tb) ? -INFINITY : (forced ? INFINITY : imp);
        int rank = 0;
        for (int j = 0; j < 64; ++j) { const float vj = __shfl(v, j); rank += (vj > v || (vj == v && j < mb)) ? 1 : 0; }
        const bool sel = (rank < 16) && (mb <= tb);
        selmask = __ballot(sel);
    }
    __syncthreads();
    {
        float sc[16][4]; float mx[4] = {-INFINITY, -INFINITY, -INFINITY, -INFINITY};
        unsigned long long mk = selmask;
#pragma unroll
        for (int i = 0; i < 16; ++i) {
            float s0 = -INFINITY, s1 = -INFINITY, s2 = -INFINITY, s3 = -INFINITY;
            if (mk) {
                const int blk = __builtin_ctzll(mk); mk &= mk - 1;
                const int pos = blk * 64 + lane;
                if (pos <= t) {
                    dot4(qs, proj + (size_t)(b * SEQ + pos) * NSP + 1536 + g * 128, s0, s1, s2, s3);
                    const int dist = t - pos;
                    s0 += bt0[dist]; s1 += bt0[4096 + dist]; s2 += bt0[8192 + dist]; s3 += bt0[12288 + dist];
                }
            }
            sc[i][0] = s0; sc[i][1] = s1; sc[i][2] = s2; sc[i][3] = s3;
            mx[0] = fmaxf(mx[0], s0); mx[1] = fmaxf(mx[1], s1); mx[2] = fmaxf(mx[2], s2); mx[3] = fmaxf(mx[3], s3);
        }
#pragma unroll
        for (int hh = 0; hh < 4; ++hh) {
            const float mm = wave_max(mx[hh]);
            float sum = 0.f;
#pragma unroll
            for (int i = 0; i < 16; ++i) { const float pp = (sc[i][hh] == -INFINITY) ? 0.f : expf(sc[i][hh] - mm); sc[i][hh] = pp; sum += pp; }
            sum = wave_sum(sum);
            const float inv = sum > 0.f ? 1.f / sum : 0.f;
#pragma unroll
            for (int i = 0; i < 16; ++i) ps[hh][i * 64 + lane] = sc[i][hh] * inv;
        }
        __syncthreads();
#pragma unroll
        for (int hh = 0; hh < 4; ++hh) { oacc[hh][0] = 0.f; oacc[hh][1] = 0.f; }
        mk = selmask;
        for (int i = 0; i < 16 && mk; ++i) {
            const int blk = __builtin_ctzll(mk); mk &= mk - 1;
            const f16* vb = proj + (size_t)(b * SEQ + blk * 64) * NSP + 1792 + g * 128 + 2 * lane;
            const int nk = min(64, t - blk * 64 + 1);
            for (int r = 0; r < nk; ++r) {
                const float v0 = (float)vb[(size_t)r * NSP], v1 = (float)vb[(size_t)r * NSP + 1];
#pragma unroll
                for (int hh = 0; hh < 4; ++hh) { const float pp = ps[hh][i * 64 + r]; oacc[hh][0] += pp * v0; oacc[hh][1] += pp * v1; }
            }
        }
#pragma unroll
        for (int hh = 0; hh < 4; ++hh) { const float gg = gt[hh * 3 + 1]; ofin[hh][0] += gg * oacc[hh][0]; ofin[hh][1] += gg * oacc[hh][1]; }
    }
    __syncthreads();
    {
        float sc[8][4]; float mx[4] = {-INFINITY, -INFINITY, -INFINITY, -INFINITY};
#pragma unroll
        for (int i = 0; i < 8; ++i) {
            const int dist = i * 64 + lane; const int pos = t - dist;
            float s0 = -INFINITY, s1 = -INFINITY, s2 = -INFINITY, s3 = -INFINITY;
            if (pos >= 0) {
                dot4(qs, proj + (size_t)(b * SEQ + pos) * NSP + 2048 + g * 128, s0, s1, s2, s3);
                s0 += bt0[dist]; s1 += bt0[4096 + dist]; s2 += bt0[8192 + dist]; s3 += bt0[12288 + dist];
            }
            sc[i][0] = s0; sc[i][1] = s1; sc[i][2] = s2; sc[i][3] = s3;
            mx[0] = fmaxf(mx[0], s0); mx[1] = fmaxf(mx[1], s1); mx[2] = fmaxf(mx[2], s2); mx[3] = fmaxf(mx[3], s3);
        }
#pragma unroll
        for (int hh = 0; hh < 4; ++hh) {
            const float mm = wave_max(mx[hh]);
            float sum = 0.f;
#pragma unroll
            for (int i = 0; i < 8; ++i) { const float pp = (sc[i][hh] == -INFINITY) ? 0.f : expf(sc[i][hh] - mm); sc[i][hh] = pp; sum += pp; }
            sum = wave_sum(sum);
            const float inv = sum > 0.f ? 1.f / sum : 0.f;
#pragma unroll
            for (int i = 0; i < 8; ++i) ps[hh][i * 64 + lane] = sc[i][hh] * inv;
        }
        __syncthreads();
#pragma unroll
        for (int hh = 0; hh < 4; ++hh) { oacc[hh][0] = 0.f; oacc[hh][1] = 0.f; }
        const int nk = min(512, t + 1);
        for (int dist = 0; dist < nk; ++dist) {
            const f16* vb = proj + (size_t)(b * SEQ + t - dist) * NSP + 2304 + g * 128 + 2 * lane;
            const float v0 = (float)vb[0], v1 = (float)vb[1];
#pragma unroll
            for (int hh = 0; hh < 4; ++hh) { const float pp = ps[hh][dist]; oacc[hh][0] += pp * v0; oacc[hh][1] += pp * v1; }
        }
#pragma unroll
        for (int hh = 0; hh < 4; ++hh) { const float gg = gt[hh * 3 + 2]; ofin[hh][0] += gg * oacc[hh][0]; ofin[hh][1] += gg * oacc[hh][1]; }
    }
#pragma unroll
    for (int hh = 0; hh < 4; ++hh) { f16* o = yout + m * 1024 + (g * 4 + hh) * 128 + 2 * lane; o[0] = (f16)ofin[hh][0]; o[1] = (f16)ofin[hh][1]; }
}

__global__ void __launch_bounds__(256) k_route(const float* __restrict__ x, const float* __restrict__ modl, int sh_off, int sc_off, const float* __restrict__ wr,
                                               int* __restrict__ tope, float* __restrict__ topw, int* __restrict__ posn, unsigned* __restrict__ ctl) {
    const int wv = threadIdx.x >> 6, lane = threadIdx.x & 63;
    const int m = blockIdx.x * 4 + wv, b = m >> 12;
    float lg[8];
#pragma unroll
    for (int e = 0; e < 8; ++e) lg[e] = 0.f;
    for (int j = 0; j < 16; ++j) {
        const int d = j * 64 + lane;
        const float hv = x[(size_t)m * 1024 + d] * (1.f + modl[b * 6144 + sc_off + d]) + modl[b * 6144 + sh_off + d];
        const f32x4 w0 = *(const f32x4*)(wr + d * 8), w1 = *(const f32x4*)(wr + d * 8 + 4);
        lg[0] += hv * w0[0]; lg[1] += hv * w0[1]; lg[2] += hv * w0[2]; lg[3] += hv * w0[3];
        lg[4] += hv * w1[0]; lg[5] += hv * w1[1]; lg[6] += hv * w1[2]; lg[7] += hv * w1[3];
    }
#pragma unroll
    for (int e = 0; e < 8; ++e) lg[e] = wave_sum(lg[e]);
    if (lane == 0) {
        int e0 = 0; float l0 = lg[0];
#pragma unroll
        for (int e = 1; e < 8; ++e) if (lg[e] > l0) { l0 = lg[e]; e0 = e; }
        int e1 = -1; float l1 = -INFINITY;
#pragma unroll
        for (int e = 0; e < 8; ++e) if (e != e0 && lg[e] > l1) { l1 = lg[e]; e1 = e; }
        const float w0 = 1.f / (1.f + expf(l1 - l0)), w1 = 1.f - w0;
        tope[m * 2] = e0; tope[m * 2 + 1] = e1; topw[m * 2] = w0; topw[m * 2 + 1] = w1;
        posn[m * 2] = (int)atomicAdd(ctl + CW_CNT + e0, 1u);
        posn[m * 2 + 1] = (int)atomicAdd(ctl + CW_CNT + e1, 1u);
    }
}
__global__ void k_moe_off(unsigned* __restrict__ ctl) {
    if (threadIdx.x == 0) {
        unsigned off = 0;
        for (int e = 0; e < 8; ++e) {
            ctl[CW_OFF + e] = off;
            const unsigned pad = (ctl[CW_CNT + e] + 255u) / 256u;
            for (unsigned i = 0; i < pad; ++i) ctl[CW_TEXP + off / 256u + i] = (unsigned)e + 1u;
            off += pad * 256u;
        }
        ctl[CW_OFF + 8] = off;
    }
}
__global__ void k_moe_scatter(const int* __restrict__ tope, const float* __restrict__ topw, const int* __restrict__ posn, unsigned* __restrict__ ctl, int* __restrict__ slot) {
    const int i = blockIdx.x * 256 + threadIdx.x;
    const int e = tope[i];
    const int s = (int)ctl[CW_OFF + e] + posn[i];
    slot[i] = s;
    ((int*)ctl)[CW_ROWTOK + s] = i >> 1;
    ((float*)ctl)[CW_ROWW + s] = topw[i];
}

static void gemm(hipStream_t st, bool dual, const GemmP& p) {
    dim3 grid((p.N + 63) / 64, p.M / 128);
    if (dual) hipLaunchKernelGGL(k_gemm<true>, grid, dim3(256), 0, st, p);
    else hipLaunchKernelGGL(k_gemm<false>, grid, dim3(256), 0, st, p);
}

extern "C" void kernel_launch(void* const* d_in, const int* in_sizes, int n_in, void* d_out, int out_size, void* d_ws, size_t ws_size, hipStream_t stream) {
    if (n_in != 26 || ws_size < WS_END) { fprintf(stderr, "kernel_launch: unexpected n_in %d / ws_size %zu\n", n_in, ws_size); return; }
    const float* x_in = (const float*)d_in[0]; const float* c = (const float*)d_in[1]; const float* rel_bias = (const float*)d_in[2];
    const float* ada_w = (const float*)d_in[3]; const float* ada_b = (const float*)d_in[4]; const float* ln_g = (const float*)d_in[5]; const float* ln_b = (const float*)d_in[6];
    const float* ab_w_in = (const float*)d_in[7]; const float* gla_wg2 = (const float*)d_in[8]; const float* gla_bg2 = (const float*)d_in[9]; const float* gla_norm_g = (const float*)d_in[10];
    const float* ab_w_out = (const float*)d_in[11]; const float* ffn_w1 = (const float*)d_in[12]; const float* ffn_w3 = (const float*)d_in[13]; const float* ffn_w2 = (const float*)d_in[14];
    const float* nsa_w_in = (const float*)d_in[15]; const float* nsa_pos = (const float*)d_in[16]; const float* w1k = (const float*)d_in[17]; const float* w2k = (const float*)d_in[18];
    const float* w1v = (const float*)d_in[19]; const float* w2v = (const float*)d_in[20]; const float* nsa_w_out = (const float*)d_in[21]; const float* moe_router = (const float*)d_in[22];
    const float* moe_w1 = (const float*)d_in[23]; const float* moe_w3 = (const float*)d_in[24]; const float* moe_w2 = (const float*)d_in[25];
    char* ws = (char*)d_ws;
    unsigned* ctl = (unsigned*)(ws + WS_CTL);
    float* MOD = (float*)(ws + WS_MOD); float* BIAS = (float*)(ws + WS_BIAS); float* KMEAN = (float*)(ws + WS_KMEAN);
    f16* KCMP = (f16*)(ws + WS_KCMP); f16* VCMP = (f16*)(ws + WS_VCMP);
    int* TOPE = (int*)(ws + WS_MOEI); float* TOPW = (float*)(ws + WS_MOEI + 128 * 1024); int* POSN = (int*)(ws + WS_MOEI + 256 * 1024); int* SLOT = (int*)(ws + WS_MOEI + 384 * 1024);
    float* GLR = (float*)(ws + WS_GLR); float* GATES = (float*)(ws + WS_GATES);
    f16* H = (f16*)(ws + WS_H); f16* PROJ = (f16*)(ws + WS_PROJ); float* LA = (float*)(ws + WS_LA); float* GLAO = (float*)(ws + WS_GLAO);
    f16* YCAT = (f16*)(ws + WS_YCAT); float* Y = (float*)(ws + WS_Y); f16* FFI = (f16*)(ws + WS_FFI); f16* INTER = (f16*)(ws + WS_INTER); float* YA = (float*)(ws + WS_YA);
    float* X = (float*)d_out;

    hipLaunchKernelGGL(k_mod, dim3(96), dim3(256), 0, stream, c, ada_w, ada_b, MOD);
    hipLaunchKernelGGL(k_bias, dim3(128), dim3(256), 0, stream, rel_bias, BIAS);
    hipLaunchKernelGGL(k_modulate, dim3(NT * 4), dim3(256), 0, stream, x_in, MOD, 0, 1024, H);

    for (int i = 0; i < DEPTH; ++i) {
        const int j = i >> 1;
        const float* modl = MOD + (size_t)i * 4 * 6144;
        const float* modn = MOD + (size_t)(i + 1 < DEPTH ? i + 1 : i) * 4 * 6144;
        const float* xin = (i == 0) ? x_in : X;
        if ((i & 1) == 0) {
            GemmP p{}; p.A = H; p.lda = 1024; p.W = ab_w_in + (size_t)j * 1024 * ABW; p.ldw = ABW; p.M = NT; p.N = ABW; p.K = 1024; p.mode = 0;
            p.C16 = PROJ; p.ldc16 = ABP; p.nsplit = ABP; p.C32 = GLR; p.ldc32 = 16;
            gemm(stream, false, p);
            hipLaunchKernelGGL(k_gla_gate, dim3(NT), dim3(256), 0, stream, GLR, gla_wg2 + j * 16 * 256, gla_bg2 + j * 256, LA);
            hipLaunchKernelGGL(k_kmean, dim3(512), dim3(64), 0, stream, PROJ, KMEAN);
            hipLaunchKernelGGL(k_moba, dim3(NT * 8 / 4), dim3(256), 0, stream, PROJ, KMEAN, BIAS, YCAT);
            hipLaunchKernelGGL(k_gla, dim3(256), dim3(64), 0, stream, PROJ, LA, GLAO);
            hipLaunchKernelGGL(k_gla_norm, dim3(NT), dim3(256), 0, stream, GLAO, PROJ, gla_norm_g + j * 512, YCAT);
            GemmP q{}; q.A = YCAT; q.lda = 1024; q.W = ab_w_out + (size_t)j * 1024 * 1024; q.ldw = 1024; q.M = NT; q.N = 1024; q.K = 1024; q.mode = 1; q.C32 = Y; q.ldc32 = 1024;
            gemm(stream, false, q);
            hipLaunchKernelGGL(k_ln, dim3(NT / 4), dim3(256), 0, stream, xin, X, Y, (const float*)nullptr, (const int*)nullptr, modl, 2048, ln_g + (i * 2 + 0) * 1024, ln_b + (i * 2 + 0) * 1024, modl, 3072, 4096, H);
            GemmP u{}; u.A = H; u.lda = 1024; u.W = ffn_w1 + (size_t)j * 1024 * DFF; u.W3 = ffn_w3 + (size_t)j * 1024 * DFF; u.ldw = DFF; u.M = NT; u.N = DFF; u.K = 1024; u.mode = 2; u.C16 = FFI; u.ldc16 = DFF;
            gemm(stream, true, u);
            GemmP d{}; d.A = FFI; d.lda = DFF; d.W = ffn_w2 + (size_t)j * DFF * 1024; d.ldw = 1024; d.M = NT; d.N = 1024; d.K = DFF; d.mode = 1; d.C32 = Y; d.ldc32 = 1024;
            gemm(stream, false, d);
            hipLaunchKernelGGL(k_ln, dim3(NT / 4), dim3(256), 0, stream, (const float*)X, X, Y, (const float*)nullptr, (const int*)nullptr, modl, 5120, ln_g + (i * 2 + 1) * 1024, ln_b + (i * 2 + 1) * 1024, modn, 0, 1024, (i + 1 < DEPTH) ? H : (f16*)nullptr);
        } else {
            GemmP p{}; p.A = H; p.lda = 1024; p.W = nsa_w_in + (size_t)j * 1024 * NSW; p.ldw = NSW; p.M = NT; p.N = NSW; p.K = 1024; p.mode = 0;
            p.C16 = PROJ; p.ldc16 = NSP; p.nsplit = NSP; p.C32 = GATES; p.ldc32 = 24;
            gemm(stream, false, p);
            hipLaunchKernelGGL(k_sigmoid, dim3(NT * 24 / 256), dim3(256), 0, stream, GATES, NT * 24);
            hipLaunchKernelGGL(k_compress, dim3(2048), dim3(128), 0, stream, PROJ, nsa_pos + j * 4096, w1k + (size_t)j * 4096 * 128, w2k + j * 16384, w1v + (size_t)j * 4096 * 128, w2v + j * 16384, KCMP, VCMP);
            hipLaunchKernelGGL(k_nsa, dim3(NB * 2 * SEQ / 2), dim3(128), 0, stream, PROJ, GATES, KCMP, VCMP, BIAS, YCAT);
            GemmP q{}; q.A = YCAT; q.lda = 1024; q.W = nsa_w_out + (size_t)j * 1024 * 1024; q.ldw = 1024; q.M = NT; q.N = 1024; q.K = 1024; q.mode = 1; q.C32 = Y; q.ldc32 = 1024;
            gemm(stream, false, q);
            hipLaunchKernelGGL(k_ln, dim3(NT / 4), dim3(256), 0, stream, (const float*)X, X, Y, (const float*)nullptr, (const int*)nullptr, modl, 2048, ln_g + (i * 2 + 0) * 1024, ln_b + (i * 2 + 0) * 1024, modl, 3072, 4096, H);
            hipMemsetAsync(ws + WS_CTL, 0, CTL_BYTES, stream);
            hipLaunchKernelGGL(k_route, dim3(NT / 4), dim3(256), 0, stream, (const float*)X, modl, 3072, 4096, moe_router + j * 8192, TOPE, TOPW, POSN, ctl);
            hipLaunchKernelGGL(k_moe_off, dim3(1), dim3(64), 0, stream, ctl);
            hipLaunchKernelGGL(k_moe_scatter, dim3(NT * 2 / 256), dim3(256), 0, stream, TOPE, TOPW, POSN, ctl, SLOT);
            GemmP u{}; u.A = H; u.lda = 1024; u.rowidx = (const int*)ctl + CW_ROWTOK; u.W = moe_w1 + (size_t)j * 8 * 1024 * DFE; u.W3 = moe_w3 + (size_t)j * 8 * 1024 * DFE; u.ldw = DFE;
            u.M = MOE_ROWS; u.N = DFE; u.K = 1024; u.mode = 2; u.C16 = INTER; u.ldc16 = DFE; u.texp = (const int*)ctl + CW_TEXP; u.wstride = (size_t)1024 * DFE;
            gemm(stream, true, u);
            GemmP d{}; d.A = INTER; d.lda = DFE; d.W = moe_w2 + (size_t)j * 8 * DFE * 1024; d.ldw = 1024; d.M = MOE_ROWS; d.N = 1024; d.K = DFE; d.mode = 3; d.C32 = YA; d.ldc32 = 1024;
            d.roww = (const float*)ctl + CW_ROWW; d.texp = (const int*)ctl + CW_TEXP; d.wstride = (size_t)DFE * 1024;
            gemm(stream, false, d);
            hipLaunchKernelGGL(k_ln, dim3(NT / 4), dim3(256), 0, stream, (const float*)X, X, (const float*)nullptr, (const float*)YA, (const int*)SLOT, modl, 5120, ln_g + (i * 2 + 1) * 1024, ln_b + (i * 2 + 1) * 1024, modn, 0, 1024, (i + 1 < DEPTH) ? H : (f16*)nullptr);
        }
    }
}
```

```cpp
#include <hip/hip_runtime.h>
#include <stdint.h>
#include <stdio.h>
typedef _Float16 f16;
typedef _Float16 f16x8 __attribute__((ext_vector_type(8)));
typedef float f32x4 __attribute__((ext_vector_type(4)));

#ifndef MK_SPLIT
#define MK_SPLIT 0
#endif
constexpr int NB = 4, SEQ = 4096, DM = 1024, NT = NB * SEQ, DEPTH = 4;
constexpr int ABW = 3088, ABP = 3072;
constexpr int NSW = 2584, NSP = 2560;
constexpr int DFF = 2816, DFE = 3584, NEXP = 8;
constexpr int MOE_ROWS = 2 * NT + NEXP * 256;
constexpr float ALPHA_DN = 1.681792830507429f;
constexpr float LN_EPS = 1e-5f, RMS_EPS = 1e-6f;

constexpr size_t MiB = 1u << 20;
constexpr size_t WS_CTL = 0, CTL_BYTES = 1 * MiB;
constexpr size_t WS_MOD = 1 * MiB;
constexpr size_t WS_BIAS2 = 2 * MiB;
constexpr size_t WS_KMEAN = 3 * MiB;
constexpr size_t WS_KCMP = 4 * MiB;
constexpr size_t WS_VCMP = 5 * MiB;
constexpr size_t WS_TOPE = 6 * MiB, WS_TOPW = WS_TOPE + 128 * 1024, WS_POSN = WS_TOPW + 128 * 1024, WS_SLOT = WS_POSN + 128 * 1024, WS_ROWW = WS_SLOT + 128 * 1024;
constexpr size_t WS_DC = 8 * MiB;
constexpr size_t WS_GATES = 9 * MiB;
constexpr size_t WS_PB = 11 * MiB;
constexpr size_t WS_H = 16 * MiB;
constexpr size_t WS_PROJ = 48 * MiB;
constexpr size_t WS_LA = 144 * MiB;
constexpr size_t WS_GLAO = 160 * MiB;
constexpr size_t WS_YCAT = 192 * MiB;
constexpr size_t WS_Y = 224 * MiB;
constexpr size_t WS_FFI = 288 * MiB;
constexpr size_t WS_XG = WS_FFI;
constexpr size_t WS_INTER = 48 * MiB;
constexpr size_t WS_YA = 376 * MiB;
constexpr size_t WT_BASE = 512 * MiB;
constexpr size_t SZ_ABIN = (size_t)3328 * 1024 * 2, SZ_SQ = (size_t)1024 * 1024 * 2, SZ_FUP = (size_t)5632 * 1024 * 2, SZ_FDN = (size_t)1024 * 2816 * 2, SZ_NSIN = (size_t)2816 * 1024 * 2;
constexpr size_t SZ_MUP = (size_t)7168 * 1024 * 2, SZ_MDN = (size_t)1024 * 3584 * 2;
constexpr size_t WT_ABIN = WT_BASE, WT_ABOUT = WT_ABIN + 2 * SZ_ABIN, WT_FUP = WT_ABOUT + 2 * SZ_SQ, WT_FDN = WT_FUP + 2 * SZ_FUP, WT_NSIN = WT_FDN + 2 * SZ_FDN, WT_NSOUT = WT_NSIN + 2 * SZ_NSIN;
constexpr size_t WT_MUP = WT_NSOUT + 2 * SZ_SQ;
constexpr size_t WT_MDN = WT_MUP + 8 * SZ_MUP;
constexpr size_t WT_W1C = WT_MDN + 8 * SZ_MDN;
constexpr size_t WT_W2C = WT_W1C + 4 * MiB;
constexpr size_t WT_END = WT_W2C + 1 * MiB;
constexpr int CW_CNT = 0;
constexpr int CW_BAR = 65536;

__device__ __forceinline__ float wave_sum(float v) { for (int o = 32; o > 0; o >>= 1) v += __shfl_xor(v, o); return v; }
__device__ __forceinline__ int t5_bucket(int n) {
    if (n < 16) return n < 0 ? 0 : n;
    return 16 + (n >= 21) + (n >= 27) + (n >= 35) + (n >= 46) + (n >= 59) + (n >= 77) + (n >= 99) + (n >= 128) + (n >= 166) + (n >= 216) + (n >= 280) + (n >= 363) + (n >= 470) + (n >= 609) + (n >= 790);
}
constexpr int LDS_BYTES = 147456, RING_BYTES = 131072, LDSCTL_OFF = RING_BYTES, XB_ST_OFF = LDSCTL_OFF + 352, TEXP_OFF = LDSCTL_OFF + 1024, MOFF_OFF = LDSCTL_OFF + 2048;

#define GAS __attribute__((address_space(1)))
#define LAS __attribute__((address_space(3)))
typedef unsigned u32x4 __attribute__((ext_vector_type(4)));
typedef unsigned u32x2 __attribute__((ext_vector_type(2)));
typedef _Float16 f16x2 __attribute__((ext_vector_type(2)));
__device__ __forceinline__ unsigned pkh(float a, float b) { f16x2 v; v.x = (f16)a; v.y = (f16)b; return __builtin_bit_cast(unsigned, v); }


namespace pg8 {
typedef _Float16 h8 __attribute__((ext_vector_type(8)));
constexpr int BM = 256, BK = 64, HALF = 128, HTB = HALF * BK * 2, STAGE_BYTES = 8 * HTB, NXCD = 8, WGM = 8;
__host__ __device__ __forceinline__ int lds_byte(int r, int c) { const int st = (r >> 4) * 2 + (c >> 5), rr = r & 15, cc = c & 31, ob = rr * 64 + cc * 2; return st * 1024 + (ob ^ (((ob >> 9) & 1) << 5)); }
__host__ __device__ __forceinline__ void stage_rc(int b, int& R, int& C) { const int st = b / 1024, sb = b % 1024, swz = sb ^ (((sb >> 9) & 1) << 5); R = (st >> 1) * 16 + swz / 64; C = (st & 1) * 32 + (swz % 64) / 2; }
__host__ __device__ __forceinline__ int perm32(int rho) { const int n = rho >> 4, i = rho & 15; return 8 * (i >> 2) + 4 * n + (i & 3); }
struct Unit { int pm, pn; size_t boff; };
struct Gemm { const f16* A; const f16* Bt; int M, N, K; };
struct StaticOrder {
    int nM, nN, nwg, G, c;
    __device__ void init(int M, int N, int G_, int c_) { nM = M / BM; nN = N / BM; nwg = nM * nN; G = G_; c = c_; }
    __device__ bool next(int i, Unit& u) const {
        const long L = (long)i * G + c; if (L >= nwg) return false;
        int wgid = (int)L; { const int q = nwg / NXCD, r = nwg % NXCD, xcd = wgid % NXCD, off = wgid / NXCD; wgid = (xcd < r ? xcd * (q + 1) : r * (q + 1) + (xcd - r) * q) + off; }
        const int nig = WGM * nN, gid = wgid / nig, fm = gid * WGM, gsz = (nM - fm) < WGM ? (nM - fm) : WGM;
        u.pm = fm + ((wgid % nig) % gsz); u.pn = (wgid % nig) / gsz; u.boff = 0; return true;
    }
    __device__ __forceinline__ void a_ready(const Unit&) const {}
    __device__ __forceinline__ void done(const Unit&) const {}
};
struct MoeOrder : StaticOrder {
    const LAS unsigned* texp; size_t estride;
    __device__ bool next(int i, Unit& u) const { if (!StaticOrder::next(i, u)) return false; u.boff = (size_t)(texp[u.pm] - 1u) * estride; return true; }
};
struct EpiF32 {
    static constexpr bool PERM = false, AFTER_DRAIN = false;
    float* C; int ldc; const float* roww;
    __device__ __forceinline__ void operator()(const f32x4 (&acc)[2][2][4][2], const Unit& u, int wr, int wc, int fr, int fq) const {
        const int row0 = u.pm * BM + wr * 64 + fr, col0 = u.pn * BM + wc * 32 + 4 * fq;
#pragma unroll
        for (int ai = 0; ai < 2; ++ai)
#pragma unroll
            for (int m = 0; m < 4; ++m) { const int row = row0 + ai * HALF + m * 16; float* rowp = C + (size_t)row * ldc + col0; const float w = roww ? roww[row] : 1.f;
#pragma unroll
                for (int bj = 0; bj < 2; ++bj)
#pragma unroll
                    for (int n = 0; n < 2; ++n) *(f32x4*)(rowp + bj * HALF + n * 16) = acc[ai][bj][m][n] * w; }
    }
};
template <int MODE> struct EpiIn {
    static constexpr bool PERM = true, AFTER_DRAIN = false;
    f16* O; int nfull; float* X32; const float* bias;
    __device__ __forceinline__ void operator()(const f32x4 (&acc)[2][2][4][2], const Unit& u, int wr, int wc, int fr, int fq) const {
        const int row0 = u.pm * BM + wr * 64 + fr; const int ldc = nfull * BM;
        if (u.pn < nfull) {
            const int col0 = u.pn * BM + wc * 32 + 8 * fq;
#pragma unroll
            for (int ai = 0; ai < 2; ++ai)
#pragma unroll
                for (int m = 0; m < 4; ++m) { f16* rowp = O + (size_t)(row0 + ai * HALF + m * 16) * ldc + col0;
#pragma unroll
                    for (int bj = 0; bj < 2; ++bj) { const f32x4 v0 = acc[ai][bj][m][0], v1 = acc[ai][bj][m][1];
                        u32x4 w; w.x = pkh(v0[0], v0[1]); w.y = pkh(v0[2], v0[3]); w.z = pkh(v1[0], v1[1]); w.w = pkh(v1[2], v1[3]);
                        *(u32x4*)(rowp + bj * HALF) = w; } }
        } else if (MODE == 0) {
            const int c0 = wc * 32 + 8 * fq;
#pragma unroll
            for (int bj = 0; bj < 2; ++bj)
#pragma unroll
                for (int n = 0; n < 2; ++n) { const f32x4 bv = *(const f32x4*)(bias + c0 + bj * HALF + 4 * n);
#pragma unroll
                    for (int ai = 0; ai < 2; ++ai)
#pragma unroll
                        for (int m = 0; m < 4; ++m) { const f32x4 z = acc[ai][bj][m][n] + bv; f32x4 o;
#pragma unroll
                            for (int e = 0; e < 4; ++e) o[e] = (fminf(z[e], 0.f) - log1pf(expf(-fabsf(z[e])))) * (1.f / 16.f);
                            *(f32x4*)(X32 + (size_t)(row0 + ai * HALF + m * 16) * 256 + c0 + bj * HALF + 4 * n) = o; } }
        } else {
            if (wc == 0 && fq < 3) {
#pragma unroll
                for (int n = 0; n < 2; ++n)
#pragma unroll
                    for (int ai = 0; ai < 2; ++ai)
#pragma unroll
                        for (int m = 0; m < 4; ++m) { const f32x4 z = acc[ai][0][m][n]; f32x4 o;
#pragma unroll
                            for (int e = 0; e < 4; ++e) o[e] = 1.f / (1.f + expf(-z[e]));
                            *(f32x4*)(X32 + (size_t)(row0 + ai * HALF + m * 16) * 24 + 8 * fq + 4 * n) = o; }
            }
        }
    }
};
struct EpiSwiglu {
    static constexpr bool PERM = true, AFTER_DRAIN = false;
    f16* O; int ldc;
    __device__ __forceinline__ void operator()(const f32x4 (&acc)[2][2][4][2], const Unit& u, int wr, int wc, int fr, int fq) const {
        const int row0 = u.pm * BM + wr * 64 + fr, col0 = u.pn * HALF + wc * 32 + 8 * fq;
#pragma unroll
        for (int ai = 0; ai < 2; ++ai)
#pragma unroll
            for (int m = 0; m < 4; ++m) { f16* rowp = O + (size_t)(row0 + ai * HALF + m * 16) * ldc + col0; float h[8];
#pragma unroll
                for (int n = 0; n < 2; ++n)
#pragma unroll
                    for (int e = 0; e < 4; ++e) { const float a = acc[ai][0][m][n][e], b = acc[ai][1][m][n][e]; h[n * 4 + e] = a / (1.f + __expf(-a)) * b; }
                u32x4 w; w.x = pkh(h[0], h[1]); w.y = pkh(h[2], h[3]); w.z = pkh(h[4], h[5]); w.w = pkh(h[6], h[7]);
                *(u32x4*)rowp = w; }
    }
};

template <class Epi, class Sched, bool ALIGN_EPI = false, bool SP2 = false>
__device__ __forceinline__ void gemm_phase(LAS unsigned char* lds, const Gemm g, const Sched& S, const Epi& E, const int tid) {
    const int wid = __builtin_amdgcn_readfirstlane(tid >> 6), lane = tid & 63, wr = wid >> 2, wc = wid & 3, fr = lane & 15, fq = lane >> 4;
    const int K = g.K, nt = K / BK;
    unsigned voffA[2], voffB[2];
#pragma unroll
    for (int i = 0; i < 2; ++i) { int R, C; stage_rc(tid * 16 + i * 8192, R, C); const int Rb = Epi::PERM ? ((R & ~31) + perm32(R & 31)) : R;
        voffA[i] = (unsigned)(R * K + C) * 2u; voffB[i] = (unsigned)(Rb * K + C) * 2u; }
    const size_t kstep = (size_t)(BK * 2);
    const size_t hstep = (size_t)HALF * K * 2;
    const size_t tstep = 2 * hstep;
    const unsigned ldsw = (unsigned)wid * 1024u;
    const int aoff = lds_byte(wr * 64 + fr, fq * 8), boff = lds_byte(wc * 32 + fr, fq * 8);
#define PG8_SA(b, h) (((b) * 2 + (h)) * HTB)
#define PG8_SB(b, h) ((4 + (b) * 2 + (h)) * HTB)
#define PG8_STAGE(bufoff, gbase, voff) do { _Pragma("unroll") for (int _i = 0; _i < 2; ++_i) \
        __builtin_amdgcn_global_load_lds((const unsigned*)((const char*)(gbase) + (voff)[_i]), (LAS unsigned*)(lds + (bufoff) + ldsw + _i * 8192), 16, 0, 0); } while (0)
#define PG8_LDA(dst, b, h) do { _Pragma("unroll") for (int m = 0; m < 4; ++m) _Pragma("unroll") for (int k = 0; k < 2; ++k) dst[m][k] = *(const LAS h8*)(lds + PG8_SA(b, h) + aoff + m * 2048 + k * 1024); } while (0)
#define PG8_LDB(dst, b, h) do { _Pragma("unroll") for (int n = 0; n < 2; ++n) _Pragma("unroll") for (int k = 0; k < 2; ++k) dst[n][k] = *(const LAS h8*)(lds + PG8_SB(b, h) + boff + n * 2048 + k * 1024); } while (0)
#define PG8_MMA(ai, bj, At, Bt) do { __builtin_amdgcn_s_setprio(1); _Pragma("unroll") for (int m = 0; m < 4; ++m) _Pragma("unroll") for (int n = 0; n < 2; ++n) _Pragma("unroll") for (int k = 0; k < 2; ++k) \
        acc[ai][bj][m][n] = __builtin_amdgcn_mfma_f32_16x16x32_f16(Bt[n][k], At[m][k], acc[ai][bj][m][n], 0, 0, 0); __builtin_amdgcn_s_setprio(0); } while (0)
#define PG8_WAIT_V(n) asm volatile("s_waitcnt vmcnt(" #n ")" ::: "memory")
#define PG8_WAIT_L(n) asm volatile("s_waitcnt lgkmcnt(" #n ")" ::: "memory")
#define PG8_BAR __builtin_amdgcn_s_barrier()
#define PG8_SCHED __builtin_amdgcn_sched_barrier(0)
    Unit cur, nxt; int ui = 0;
    if (!S.next(0, cur)) return;
    f32x4 acc[2][2][4][2];
#pragma unroll
    for (int a = 0; a < 2; ++a)
#pragma unroll
        for (int b = 0; b < 2; ++b)
#pragma unroll
            for (int m = 0; m < 4; ++m)
#pragma unroll
                for (int n = 0; n < 2; ++n) acc[a][b][m][n] = (f32x4){0.f, 0.f, 0.f, 0.f};
    h8 At[4][2], B0[2][2], B1[2][2];
    const char* cA = (const char*)g.A + (size_t)cur.pm * tstep; const char* cB = (const char*)g.Bt + cur.boff + (size_t)cur.pn * tstep;
    S.a_ready(cur);
    if constexpr (SP2) {
        PG8_STAGE(PG8_SB(0, 0), cB, voffB); PG8_STAGE(PG8_SB(0, 1), cB + hstep, voffB); PG8_STAGE(PG8_SA(0, 0), cA, voffA); PG8_STAGE(PG8_SA(0, 1), cA + hstep, voffA);
        if (wr == 1) PG8_BAR;
        PG8_WAIT_V(2); PG8_BAR;
        PG8_STAGE(PG8_SB(1, 0), cB + kstep, voffB); PG8_STAGE(PG8_SA(1, 0), cA + kstep, voffA); PG8_STAGE(PG8_SB(1, 1), cB + hstep + kstep, voffB);
        PG8_WAIT_V(6); PG8_BAR;
    } else {
        PG8_STAGE(PG8_SB(0, 0), cB, voffB); PG8_STAGE(PG8_SA(0, 0), cA, voffA); PG8_STAGE(PG8_SB(0, 1), cB + hstep, voffB); PG8_STAGE(PG8_SA(0, 1), cA + hstep, voffA);
        if (wr == 1) PG8_BAR;
        PG8_WAIT_V(4); PG8_BAR;
        PG8_STAGE(PG8_SB(1, 0), cB + kstep, voffB); PG8_STAGE(PG8_SA(1, 0), cA + kstep, voffA); PG8_STAGE(PG8_SB(1, 1), cB + hstep + kstep, voffB);
        PG8_WAIT_V(6); PG8_BAR;
    }
    for (;;) {
        const bool has_next = S.next(ui + 1, nxt);
        const char* nA = has_next ? (const char*)g.A + (size_t)nxt.pm * tstep : cA; const char* nB = has_next ? (const char*)g.Bt + nxt.boff + (size_t)nxt.pn * tstep : cB;
        for (int t = 0; t < nt; t += 2) {
            const bool last = (t == nt - 2);
            const char* a1 = cA + (size_t)(t + 1) * kstep;
            const char* a2 = last ? nA : cA + (size_t)(t + 2) * kstep; const char* b2 = last ? nB : cB + (size_t)(t + 2) * kstep;
            const char* a3 = a2 + kstep; const char* b3 = b2 + kstep;
            if (last && has_next) S.a_ready(nxt);
            if constexpr (SP2) {
            PG8_LDB(B0, 0, 0); PG8_LDB(B1, 0, 1); PG8_SCHED; PG8_LDA(At, 0, 0); PG8_STAGE(PG8_SA(1, 1), a1 + hstep, voffA);
            PG8_WAIT_V(8); PG8_WAIT_L(0); PG8_BAR; PG8_MMA(0, 0, At, B0); PG8_MMA(0, 1, At, B1); PG8_BAR; PG8_SCHED;
            PG8_LDA(At, 0, 1); PG8_STAGE(PG8_SB(0, 0), b2, voffB); PG8_STAGE(PG8_SB(0, 1), b2 + hstep, voffB); PG8_STAGE(PG8_SA(0, 0), a2, voffA);
            PG8_WAIT_V(8); PG8_WAIT_L(0); PG8_BAR; PG8_MMA(1, 0, At, B0); PG8_MMA(1, 1, At, B1); PG8_BAR; PG8_SCHED;
            PG8_LDB(B0, 1, 0); PG8_LDB(B1, 1, 1); PG8_SCHED; PG8_LDA(At, 1, 0); PG8_STAGE(PG8_SA(0, 1), a2 + hstep, voffA);
            PG8_WAIT_V(8); PG8_WAIT_L(0); PG8_BAR; PG8_MMA(0, 0, At, B0); PG8_MMA(0, 1, At, B1); PG8_BAR; PG8_SCHED;
            PG8_LDA(At, 1, 1); PG8_STAGE(PG8_SB(1, 0), b3, voffB); PG8_STAGE(PG8_SB(1, 1), b3 + hstep, voffB); PG8_STAGE(PG8_SA(1, 0), a3, voffA);
            PG8_WAIT_V(8); PG8_WAIT_L(0); PG8_BAR; PG8_MMA(1, 0, At, B0); PG8_MMA(1, 1, At, B1); PG8_BAR; PG8_SCHED;
            } else {
            PG8_LDB(B0, 0, 0); PG8_SCHED; PG8_LDA(At, 0, 0); PG8_STAGE(PG8_SA(1, 1), a1 + hstep, voffA);
            PG8_WAIT_L(8); PG8_BAR; PG8_WAIT_L(0); PG8_MMA(0, 0, At, B0); PG8_BAR; PG8_SCHED;
            PG8_LDB(B1, 0, 1); PG8_STAGE(PG8_SB(0, 0), b2, voffB);
            PG8_BAR; PG8_WAIT_L(0); PG8_MMA(0, 1, At, B1); PG8_BAR;
            PG8_LDA(At, 0, 1); PG8_STAGE(PG8_SA(0, 0), a2, voffA);
            PG8_BAR; PG8_WAIT_L(0); PG8_MMA(1, 0, At, B0); PG8_BAR; PG8_SCHED;
            PG8_STAGE(PG8_SB(0, 1), b2 + hstep, voffB);
            PG8_WAIT_V(6); PG8_BAR; PG8_MMA(1, 1, At, B1); PG8_BAR;
            PG8_LDB(B0, 1, 0); PG8_SCHED; PG8_LDA(At, 1, 0); PG8_STAGE(PG8_SA(0, 1), a2 + hstep, voffA);
            PG8_WAIT_L(8); PG8_BAR; PG8_WAIT_L(0); PG8_MMA(0, 0, At, B0); PG8_BAR; PG8_SCHED;
            PG8_LDB(B1, 1, 1); PG8_STAGE(PG8_SB(1, 0), b3, voffB);
            PG8_BAR; PG8_WAIT_L(0); PG8_MMA(0, 1, At, B1); PG8_BAR;
            PG8_LDA(At, 1, 1); PG8_STAGE(PG8_SA(1, 0), a3, voffA);
            PG8_BAR; PG8_WAIT_L(0); PG8_MMA(1, 0, At, B0); PG8_BAR; PG8_SCHED;
            PG8_STAGE(PG8_SB(1, 1), b3 + hstep, voffB);
            PG8_WAIT_V(6); PG8_BAR; PG8_MMA(1, 1, At, B1); PG8_BAR;
            }
        }
        if constexpr (ALIGN_EPI) { if (wr == 0) PG8_BAR; }
        if constexpr (!Epi::AFTER_DRAIN) { E(acc, cur, wr, wc, fr, fq); S.done(cur); }
        if (!has_next) break;
#pragma unroll
        for (int a = 0; a < 2; ++a)
#pragma unroll
            for (int b = 0; b < 2; ++b)
#pragma unroll
                for (int m = 0; m < 4; ++m)
#pragma unroll
                    for (int n = 0; n < 2; ++n) acc[a][b][m][n] = (f32x4){0.f, 0.f, 0.f, 0.f};
        cur = nxt; cA = nA; cB = nB; ++ui;
        if constexpr (ALIGN_EPI) { if (wr == 1) PG8_BAR; }
    }
    PG8_WAIT_V(0);
    if constexpr (!ALIGN_EPI) { if (wr == 0) PG8_BAR; }
    PG8_BAR;
    if constexpr (Epi::AFTER_DRAIN) { E.fused(acc, cur, wr, wc, fr, fq, lds, wid, lane); S.done(cur); }
#undef PG8_SA
#undef PG8_SB
#undef PG8_STAGE
#undef PG8_LDA
#undef PG8_LDB
#undef PG8_MMA
#undef PG8_WAIT_V
#undef PG8_WAIT_L
#undef PG8_BAR
#undef PG8_SCHED
}
}


typedef float f32x16 __attribute__((ext_vector_type(16)));
typedef _Float16 h8v __attribute__((ext_vector_type(8)));
typedef _Float16 h4v __attribute__((ext_vector_type(4)));
template <int DH> __device__ __forceinline__ unsigned kv_off(unsigned row, unsigned ch) {
    if (DH == 128) return 256u * row + 16u * (ch ^ (((row & 3u) << 2) | ((row >> 2) & 3u)));
    else return 128u * row + 16u * (ch ^ ((((row >> 1) & 1u) << 2) | ((row >> 2) & 3u)));
}
template <int OFF> __device__ __forceinline__ void tr_read2(unsigned a0, unsigned a1, h4v& r0, h4v& r1) {
    asm volatile("ds_read_b64_tr_b16 %0, %2 offset:%4\n\tds_read_b64_tr_b16 %1, %3 offset:%4\n\ts_waitcnt lgkmcnt(0)" : "=&v"(r0), "=&v"(r1) : "v"(a0), "v"(a1), "i"(OFF) : "memory"); }
template <int DH> struct LaneOffs { unsigned k[DH / 16]; unsigned v[DH / 32][2]; };
template <int DH> __device__ __forceinline__ void lane_offs(LaneOffs<DH>& o, int lane) {
    const unsigned lr = lane & 31, hh = lane >> 5, blk = (lane >> 4) & 1, q4 = (lane & 15) >> 2, p4 = lane & 3;
#pragma unroll
    for (int st = 0; st < DH / 16; ++st) o.k[st] = kv_off<DH>(lr, 2u * st + hh);
#pragma unroll
    for (int c = 0; c < DH / 32; ++c)
#pragma unroll
        for (int jj = 0; jj < 2; ++jj) o.v[c][jj] = kv_off<DH>(4u * hh + q4 + 8u * jj, 4u * c + 2u * blk + (p4 >> 1)) + 8u * (p4 & 1);
}
template <int DH> struct TileOffs { unsigned o[DH / 64]; };
template <int DH> __device__ __forceinline__ void tile_offs(TileOffs<DH>& t, unsigned pitch, int wave, int lane) {
#pragma unroll
    for (int i = 0; i < DH / 64; ++i) {
        const unsigned sg = wave + 8 * i;
        const unsigned row = (DH == 128) ? (4u * sg + (lane >> 4)) : (8u * sg + (lane >> 3));
        const unsigned cp = (DH == 128) ? (lane & 15) : (lane & 7);
        const unsigned ch = (kv_off<DH>(row, cp) - (DH * 2u) * row) >> 4;
        t.o[i] = (row * pitch + ch * 8u) * 2u;
    }
}
template <int DH> __device__ __forceinline__ void tile_dma(LAS unsigned char* dst, const f16* base, const TileOffs<DH>& t, int wave) {
#pragma unroll
    for (int i = 0; i < DH / 64; ++i)
        __builtin_amdgcn_global_load_lds((const unsigned*)((const char*)base + t.o[i]), (LAS unsigned*)(dst + (wave + 8 * i) * 1024), 16, 0, 0);
}
template <int DH, int KB, int HS>
__device__ __forceinline__ void pv_step(unsigned vbase, const LaneOffs<DH>& lo, const f32x16 (&s)[2], f32x16 (&oacc)[DH / 32]) {
    h8v pf;
#pragma unroll
    for (int j = 0; j < 8; ++j) pf[j] = (f16)s[KB][8 * HS + j];
#pragma unroll
    for (int c = 0; c < DH / 32; ++c) {
        h4v v0, v1;
        tr_read2<(32 * KB + 16 * HS) * DH * 2>(vbase + lo.v[c][0], vbase + lo.v[c][1], v0, v1);
        h8v a; a[0] = v0[0]; a[1] = v0[1]; a[2] = v0[2]; a[3] = v0[3]; a[4] = v1[0]; a[5] = v1[1]; a[6] = v1[2]; a[7] = v1[3];
        oacc[c] = __builtin_amdgcn_mfma_f32_32x32x16_f16(a, pf, oacc[c], 0, 0, 0);
    }
}
template <int DH, int MODE, class MaskF>
__device__ __forceinline__ void attn_tile(const LAS unsigned char* Kt, const LAS unsigned char* Vt, const LaneOffs<DH>& lo, const h8v (&qf)[DH / 16], f32x16 (&oacc)[DH / 32], float& m, float& l, const MaskF& mf, int lane,
                                          f32x16 (&s)[2], float pscale) {
    const unsigned hh = lane >> 5;
#pragma unroll
    for (int kb = 0; kb < 2; ++kb) {
#pragma unroll
        for (int r = 0; r < 16; ++r) s[kb][r] = 0.f;
#pragma unroll
        for (int st = 0; st < DH / 16; ++st) {
            const h8v a = *(const LAS h8v*)(Kt + lo.k[st] + kb * 32 * DH * 2);
            s[kb] = __builtin_amdgcn_mfma_f32_32x32x16_f16(a, qf[st], s[kb], 0, 0, 0);
            if ((st & 3) == 3) __builtin_amdgcn_sched_barrier(0);
        }
    }
    float mx = -1e30f;
#pragma unroll
    for (int kb = 0; kb < 2; ++kb)
#pragma unroll
        for (int r = 0; r < 16; ++r) { const int kk = 32 * kb + (r & 3) + 8 * (r >> 2) + 4 * (int)hh; const float v = mf(kk, s[kb][r]); s[kb][r] = v; mx = fmaxf(mx, v); }
    if (MODE != 2) {
        mx = fmaxf(mx, __shfl_xor(mx, 32));
        const float mn = fmaxf(m, mx), alpha = __builtin_amdgcn_exp2f(m - mn);
        m = mn;
        float ls = 0.f;
#pragma unroll
        for (int kb = 0; kb < 2; ++kb)
#pragma unroll
            for (int r = 0; r < 16; ++r) { const float p = __builtin_amdgcn_exp2f(s[kb][r] - mn); s[kb][r] = p; ls += p; }
        l = l * alpha + ls;
        if (MODE == 1) return;
#pragma unroll
        for (int c = 0; c < DH / 32; ++c)
#pragma unroll
            for (int r = 0; r < 16; ++r) oacc[c][r] *= alpha;
    } else {
#pragma unroll
        for (int kb = 0; kb < 2; ++kb)
#pragma unroll
            for (int r = 0; r < 16; ++r) s[kb][r] = __builtin_amdgcn_exp2f(s[kb][r] - m) * pscale;
    }
    const unsigned vbase = (unsigned)(size_t)Vt;
    pv_step<DH, 0, 0>(vbase, lo, s, oacc); pv_step<DH, 0, 1>(vbase, lo, s, oacc); pv_step<DH, 1, 0>(vbase, lo, s, oacc); pv_step<DH, 1, 1>(vbase, lo, s, oacc);
}
struct MobaMask {
    const LAS float* btab; int t, key0; bool sel; float scale;
    __device__ __forceinline__ float operator()(int kk, float raw) const {
        const int dist = t - (key0 + kk);
        const int di = min(max(dist, 0), 1023);
        const float v = raw * scale + btab[di];
        return (sel && dist >= 0) ? v : -1e30f;
    }
};
__device__ __forceinline__ void moba_unit(LAS unsigned char* lds, const f16* __restrict__ PROJ, const float* __restrict__ KMEAN, const float* __restrict__ BIAS2, f16* __restrict__ YC, int b, int h, int qb, int tid) {
    const int lane = tid & 63, wave = __builtin_amdgcn_readfirstlane(tid >> 6);
    LAS float* btab = (LAS float*)(lds + 32768); LAS float* kms = (LAS float*)(lds + 36864);
    __syncthreads();
    for (int i = tid; i < 1024; i += 512) { btab[i] = BIAS2[h * 1024 + i]; kms[i] = KMEAN[(b * 8 + h) * 1024 + i]; }
    const int t = qb * 256 + 32 * wave + (lane & 31);
    const size_t mrow = (size_t)b * SEQ + t;
    const f16* qrow = PROJ + mrow * ABP + h * 64;
    h8v qf[4];
#pragma unroll
    for (int st = 0; st < 4; ++st) qf[st] = *(const h8v*)(qrow + 16 * st + 8 * (lane >> 5));
    __syncthreads();
    unsigned selmask = 0u;
    {
        float g0 = -INFINITY, g1 = -INFINITY, g2 = -INFINITY; int i0 = 31, i1 = 31, i2 = 31;
        h8v qv[8];
#pragma unroll
        for (int c = 0; c < 8; ++c) qv[c] = *(const h8v*)(qrow + 8 * c);
        for (int n = 0; n < qb; ++n) {
            float g = 0.f;
#pragma unroll
            for (int c = 0; c < 8; ++c) { const f32x4 k0 = *(const LAS f32x4*)(kms + n * 64 + 8 * c), k1 = *(const LAS f32x4*)(kms + n * 64 + 8 * c + 4);
                g += (float)qv[c][0] * k0[0]; g += (float)qv[c][1] * k0[1]; g += (float)qv[c][2] * k0[2]; g += (float)qv[c][3] * k0[3];
                g += (float)qv[c][4] * k1[0]; g += (float)qv[c][5] * k1[1]; g += (float)qv[c][6] * k1[2]; g += (float)qv[c][7] * k1[3]; }
            const bool b0 = g > g0, b1 = g > g1, b2 = g > g2;
            g2 = b1 ? g1 : (b2 ? g : g2); i2 = b1 ? i1 : (b2 ? n : i2);
            g1 = b0 ? g0 : (b1 ? g : g1); i1 = b0 ? i0 : (b1 ? n : i1);
            g0 = b0 ? g : g0;             i0 = b0 ? n : i0;
        }
        selmask = ((1u << i0) | (1u << i1) | (1u << i2)) & 0xffffu;
    }
    const f16* Kg = PROJ + (size_t)b * SEQ * ABP + 512 + h * 64;
    const f16* Vg = PROJ + (size_t)b * SEQ * ABP + 1024 + h * 64;
    const int ntiles = 4 * (qb + 1);
    TileOffs<64> to; tile_offs<64>(to, ABP, wave, lane);
    tile_dma<64>(lds, Kg, to, wave); tile_dma<64>(lds + 8192, Vg, to, wave);
    __syncthreads();
    f32x16 oacc[2];
#pragma unroll
    for (int c = 0; c < 2; ++c)
#pragma unroll
        for (int r = 0; r < 16; ++r) oacc[c][r] = 0.f;
    float m = -1e30f, l = 0.f;
    const int tmax_w = qb * 256 + 32 * wave + 31;
    LaneOffs<64> lo; lane_offs<64>(lo, lane);
    for (int kt = 0; kt < ntiles; ++kt) {
        const bool more = kt + 1 < ntiles;
        if (more) { LAS unsigned char* nb = lds + ((kt + 1) & 1) * 16384; tile_dma<64>(nb, Kg + (size_t)(kt + 1) * 64 * ABP, to, wave); tile_dma<64>(nb + 8192, Vg + (size_t)(kt + 1) * 64 * ABP, to, wave); }
        const int blk = kt >> 2;
        const bool lsel = (blk == qb) || ((selmask >> blk) & 1u);
        const bool work = (blk == qb) ? (kt * 64 <= tmax_w) : (__ballot(lsel) != 0ull);
        if (work) {
            const LAS unsigned char* kb_ = lds + (kt & 1) * 16384;
            MobaMask mf{btab, t, kt * 64, lsel, 0.125f * 1.4426950408889634f};
            f32x16 sx[2]; attn_tile<64, 0, MobaMask>(kb_, kb_ + 8192, lo, qf, oacc, m, l, mf, lane, sx, 1.f);
        }
        __syncthreads();
    }
    l += __shfl_xor(l, 32);
    const float inv = 1.f / l;
    f16* orow = YC + mrow * 1024 + h * 64 + 4 * (lane >> 5);
#pragma unroll
    for (int c = 0; c < 2; ++c)
#pragma unroll
        for (int a = 0; a < 4; ++a) {
            u32x2 w; w.x = pkh(oacc[c][4 * a] * inv, oacc[c][4 * a + 1] * inv); w.y = pkh(oacc[c][4 * a + 2] * inv, oacc[c][4 * a + 3] * inv);
            *(u32x2*)(orow + 32 * c + 8 * a) = w;
        }
}

struct CmpMask {
    const LAS float* bt; int t, n0; float scale;
    __device__ __forceinline__ float operator()(int kk, float raw) const {
        const int n = n0 + kk, dist = t - (16 * n + 31);
        const float v = raw * scale + bt[min(max(dist, 0), 1023)];
        return (dist >= 0 && n < 255) ? v : -1e30f;
    }
};
struct SlcMask {
    const LAS float* bt; int t, key0; bool sel; float scale;
    __device__ __forceinline__ float operator()(int kk, float raw) const {
        const int dist = t - (key0 + kk);
        const float v = raw * scale + bt[min(max(dist, 0), 1023)];
        return (sel && dist >= 0) ? v : -1e30f;
    }
};
struct WinMask {
    const LAS float* bt; int t, key0; float scale;
    __device__ __forceinline__ float operator()(int kk, float raw) const {
        const int dist = t - (key0 + kk);
        const float v = raw * scale + bt[min(max(dist, 0), 1023)];
        return (dist >= 0 && dist < 512) ? v : -1e30f;
    }
};
__device__ __forceinline__ void nsa_unit(LAS unsigned char* lds, const f16* __restrict__ PROJ, const float* __restrict__ GATES, const f16* __restrict__ KCMP, const f16* __restrict__ VCMP,
                                         const float* __restrict__ BIAS2, f16* __restrict__ YC, int b, int g, int qt, int tid) {
    const int lane = tid & 63, wave = __builtin_amdgcn_readfirstlane(tid >> 6), hp = wave & 3, qh = wave >> 2, hh = lane >> 5;
    LAS float* btab = (LAS float*)(lds + 65536); LAS float* IMP1 = (LAS float*)(lds + 81920); LAS float* IMP2 = (LAS float*)(lds + 98304);
    LAS unsigned long long* SEL = (LAS unsigned long long*)(lds + 114688);
    __syncthreads();
    for (int i = tid; i < 4096; i += 512) btab[i] = BIAS2[g * 4096 + i];
    for (int i = tid; i < 8192; i += 512) IMP1[i] = 0.f;
    const int ql = 32 * qh + (lane & 31), t = qt * 64 + ql, head = g * 4 + hp;
    const size_t mrow = (size_t)b * SEQ + t;
    const f16* qrow = PROJ + mrow * NSP + head * 128;
    h8v qf[8];
#pragma unroll
    for (int st = 0; st < 8; ++st) qf[st] = *(const h8v*)(qrow + 16 * st + 8 * hh);
    const LAS float* bt = btab + hp * 1024;
    const float gc = GATES[mrow * 24 + head * 3 + 0], gs = GATES[mrow * 24 + head * 3 + 1], gw = GATES[mrow * 24 + head * 3 + 2];
    const float scale = 0.08838834764831845f * 1.4426950408889634f;
    const unsigned orow_off = (unsigned)(mrow * 1024 + head * 128 + 4 * hh);
#define NSA_OROW (YC + orow_off)
    LaneOffs<128> lo; lane_offs<128>(lo, lane);
    f32x16 oacc[4]; f32x16 sx[2];
    TileOffs<128> toc, top; tile_offs<128>(toc, 128, wave, lane); tile_offs<128>(top, NSP, wave, lane);
    float m, l;
    const f16* Kc = KCMP + (size_t)(b * 2 + g) * 256 * 128; const f16* Vc = VCMP + (size_t)(b * 2 + g) * 256 * 128;
    const int tmax_w = qt * 64 + 32 * qh + 31, nvis_w = tmax_w >= 31 ? min(255, (tmax_w - 31) / 16 + 1) : 0, ntc_w = (nvis_w + 63) >> 6;
    const int nvis_g = min(255, (qt * 64 + 63 - 31) / 16 + 1), ntc = (nvis_g + 63) >> 6;
    m = -1e30f; l = 0.f;
    tile_dma<128>(lds, Kc, toc, wave);
    __syncthreads();
    for (int ct = 0; ct < ntc; ++ct) {
        const bool more = ct + 1 < ntc;
        if (more) tile_dma<128>(lds + ((ct + 1) & 1) * 32768, Kc + (size_t)(ct + 1) * 64 * 128, toc, wave);
        if (ct < ntc_w) { const LAS unsigned char* kb_ = lds + (ct & 1) * 32768; CmpMask mf{bt, t, ct * 64, scale}; attn_tile<128, 1, CmpMask>(kb_, kb_ + 16384, lo, qf, oacc, m, l, mf, lane, sx, 1.f); }
        __syncthreads();
    }
    l += __shfl_xor(l, 32);
    const float pscale = (m > -1e29f) ? 1.f / l : 0.f;
#pragma unroll
    for (int c = 0; c < 4; ++c)
#pragma unroll
        for (int r = 0; r < 16; ++r) oacc[c][r] = 0.f;
    tile_dma<128>(lds, Kc, toc, wave); tile_dma<128>(lds + 16384, Vc, toc, wave);
    __syncthreads();
    for (int ct = 0; ct < ntc; ++ct) {
        const bool more = ct + 1 < ntc;
        if (more) { LAS unsigned char* nb = lds + ((ct + 1) & 1) * 32768; tile_dma<128>(nb, Kc + (size_t)(ct + 1) * 64 * 128, toc, wave); tile_dma<128>(nb + 16384, Vc + (size_t)(ct + 1) * 64 * 128, toc, wave); }
        float a1[8], a2[8];
#pragma unroll
        for (int i = 0; i < 8; ++i) { a1[i] = 0.f; a2[i] = 0.f; }
        if (ct < ntc_w) {
            const LAS unsigned char* kb_ = lds + (ct & 1) * 32768; CmpMask mf{bt, t, ct * 64, scale};
            attn_tile<128, 2, CmpMask>(kb_, kb_ + 16384, lo, qf, oacc, m, l, mf, lane, sx, pscale);
#pragma unroll
            for (int kb = 0; kb < 2; ++kb)
#pragma unroll
                for (int a = 0; a < 4; ++a) { const float p3 = 0.5f * sx[kb][4 * a + 3]; a1[kb * 4 + a] = sx[kb][4 * a] + sx[kb][4 * a + 1] + sx[kb][4 * a + 2] + p3; a2[kb * 4 + a] = p3; }
        }
#pragma unroll
        for (int rd = 0; rd < 4; ++rd) {
            if (hp == rd) {
#pragma unroll
                for (int kb = 0; kb < 2; ++kb)
#pragma unroll
                    for (int a = 0; a < 4; ++a) { const int mb = ct * 16 + 8 * kb + 2 * a + hh; IMP1[ql * 64 + mb] += a1[kb * 4 + a]; IMP2[ql * 64 + mb] += a2[kb * 4 + a]; }
            }
            __syncthreads();
        }
    }
#pragma unroll
    for (int c = 0; c < 4; ++c)
#pragma unroll
        for (int a = 0; a < 4; ++a) { h4v d; d[0] = (f16)(oacc[c][4 * a] * gc); d[1] = (f16)(oacc[c][4 * a + 1] * gc); d[2] = (f16)(oacc[c][4 * a + 2] * gc); d[3] = (f16)(oacc[c][4 * a + 3] * gc); *(h4v*)(NSA_OROW + 32 * c + 8 * a) = d; }
    for (int qi = 0; qi < 8; ++qi) {
        const int q = wave * 8 + qi, mb = lane, tb = qt;
        const float imp = IMP1[q * 64 + mb] + (mb > 0 ? IMP2[q * 64 + mb - 1] : 0.f);
        const bool forced = (mb == 0) || (mb == tb) || (mb == tb - 1);
        const float v = (mb > tb) ? -INFINITY : (forced ? INFINITY : imp);
        int rank = 0;
#pragma unroll 1
        for (int jj = 0; jj < 64; ++jj) { const float vj = __int_as_float(__builtin_amdgcn_readlane(__float_as_int(v), jj)); rank += (vj > v || (vj == v && jj < mb)) ? 1 : 0; }
        const unsigned long long msk = __ballot((rank < 16) && (mb <= tb));
        if (lane == 0) SEL[q] = msk;
    }
    __syncthreads();
    const unsigned long long selmask = SEL[ql];
    {
        const f16* Kg = PROJ + (size_t)b * SEQ * NSP + 1536 + g * 128; const f16* Vg = PROJ + (size_t)b * SEQ * NSP + 1792 + g * 128;
        m = -1e30f; l = 0.f;
#pragma unroll
        for (int c = 0; c < 4; ++c)
#pragma unroll
            for (int r = 0; r < 16; ++r) oacc[c][r] = 0.f;
        const int nt = qt + 1;
        tile_dma<128>(lds, Kg, top, wave); tile_dma<128>(lds + 16384, Vg, top, wave);
        __syncthreads();
        for (int kt = 0; kt < nt; ++kt) {
            const bool more = kt + 1 < nt;
            if (more) { LAS unsigned char* nb = lds + ((kt + 1) & 1) * 32768; tile_dma<128>(nb, Kg + (size_t)(kt + 1) * 64 * NSP, top, wave); tile_dma<128>(nb + 16384, Vg + (size_t)(kt + 1) * 64 * NSP, top, wave); }
            const bool lsel = (selmask >> kt) & 1ull;
            if (__ballot(lsel) != 0ull) { const LAS unsigned char* kb_ = lds + (kt & 1) * 32768; SlcMask mf{bt, t, kt * 64, lsel, scale}; attn_tile<128, 0, SlcMask>(kb_, kb_ + 16384, lo, qf, oacc, m, l, mf, lane, sx, 1.f); }
            __syncthreads();
        }
        l += __shfl_xor(l, 32);
        const float sc2 = (m > -1e29f) ? gs / l : 0.f;
#pragma unroll
        for (int c = 0; c < 4; ++c)
#pragma unroll
            for (int a = 0; a < 4; ++a) { h4v d; d[0] = (f16)(oacc[c][4 * a] * sc2); d[1] = (f16)(oacc[c][4 * a + 1] * sc2); d[2] = (f16)(oacc[c][4 * a + 2] * sc2); d[3] = (f16)(oacc[c][4 * a + 3] * sc2);
                h4v* op = (h4v*)(NSA_OROW + 32 * c + 8 * a); *op = *op + d; }
    }
    {
        const f16* Kg = PROJ + (size_t)b * SEQ * NSP + 2048 + g * 128; const f16* Vg = PROJ + (size_t)b * SEQ * NSP + 2304 + g * 128;
        m = -1e30f; l = 0.f;
#pragma unroll
        for (int c = 0; c < 4; ++c)
#pragma unroll
            for (int r = 0; r < 16; ++r) oacc[c][r] = 0.f;
        const int k0 = qt > 8 ? qt - 8 : 0;
        tile_dma<128>(lds, Kg + (size_t)k0 * 64 * NSP, top, wave); tile_dma<128>(lds + 16384, Vg + (size_t)k0 * 64 * NSP, top, wave);
        __syncthreads();
        for (int kt = k0; kt <= qt; ++kt) {
            const bool more = kt + 1 <= qt; const int bi = (kt - k0) & 1;
            if (more) { LAS unsigned char* nb = lds + (bi ^ 1) * 32768; tile_dma<128>(nb, Kg + (size_t)(kt + 1) * 64 * NSP, top, wave); tile_dma<128>(nb + 16384, Vg + (size_t)(kt + 1) * 64 * NSP, top, wave); }
            { const LAS unsigned char* kb_ = lds + bi * 32768; WinMask mf{bt, t, kt * 64, scale}; attn_tile<128, 0, WinMask>(kb_, kb_ + 16384, lo, qf, oacc, m, l, mf, lane, sx, 1.f); }
            __syncthreads();
        }
        l += __shfl_xor(l, 32);
        const float sc2 = (m > -1e29f) ? gw / l : 0.f;
#pragma unroll
        for (int c = 0; c < 4; ++c)
#pragma unroll
            for (int a = 0; a < 4; ++a) { h4v d; d[0] = (f16)(oacc[c][4 * a] * sc2); d[1] = (f16)(oacc[c][4 * a + 1] * sc2); d[2] = (f16)(oacc[c][4 * a + 2] * sc2); d[3] = (f16)(oacc[c][4 * a + 3] * sc2);
                h4v* op = (h4v*)(NSA_OROW + 32 * c + 8 * a); *op = *op + d; }
    }
}

typedef short bf8v __attribute__((ext_vector_type(8)));
__device__ __forceinline__ unsigned short f2bf(float f) { const unsigned u = __builtin_bit_cast(unsigned, f); return (unsigned short)((u + 0x7fffu + ((u >> 16) & 1u)) >> 16); }
constexpr int GLD = 72;
__device__ __forceinline__ void gla_cumsum(LAS float* bs, LAS float* tot, const float* __restrict__ la, int tid) {
    const int d = tid & 63, seg = tid >> 6;
    float v[8];
#pragma unroll
    for (int i = 0; i < 8; ++i) v[i] = la[(size_t)(seg * 8 + i) * 256 + d];
#pragma unroll
    for (int i = 1; i < 8; ++i) v[i] += v[i - 1];
    tot[seg * 64 + d] = v[7];
    __syncthreads();
    float off = 0.f;
    for (int s2 = 0; s2 < seg; ++s2) off += tot[s2 * 64 + d];
#pragma unroll
    for (int i = 0; i < 8; ++i) bs[(seg * 8 + i) * 64 + d] = v[i] + off;
    __syncthreads();
}
__device__ __forceinline__ void gla_g1_unit(LAS unsigned char* lds, const f16* __restrict__ PROJ, const float* __restrict__ LA, float* __restrict__ U, float* __restrict__ Dc, int unit, int tid) {
    const int lane = tid & 63, wave = __builtin_amdgcn_readfirstlane(tid >> 6);
    const int c = unit & 63, h = (unit >> 6) & 3, b = unit >> 8;
    const size_t m0 = (size_t)b * SEQ + c * 64;
    LAS float* bs = (LAS float*)lds; LAS float* tot = (LAS float*)(lds + 16384);
    LAS f16* VT = (LAS f16*)(lds + 18432); LAS f16* KDT = (LAS f16*)(lds + 36864);
    __syncthreads();
    gla_cumsum(bs, tot, LA + m0 * 256 + h * 64, tid);
    {
        const int s_ = tid >> 3, ch = tid & 7;
        const f16* row = PROJ + (m0 + s_) * ABP;
        const h8v kv = *(const h8v*)(row + 1792 + h * 64 + 8 * ch);
        const h8v v0 = *(const h8v*)(row + 2048 + h * 128 + 8 * ch), v1 = *(const h8v*)(row + 2048 + h * 128 + 64 + 8 * ch);
#pragma unroll
        for (int j = 0; j < 8; ++j) {
            const int dk = 8 * ch + j;
            KDT[dk * GLD + s_] = (f16)((float)kv[j] * __expf(bs[63 * 64 + dk] - bs[s_ * 64 + dk]));
            VT[(8 * ch + j) * GLD + s_] = v0[j]; VT[(64 + 8 * ch + j) * GLD + s_] = v1[j];
        }
        if (tid < 64) Dc[unit * 64 + tid] = __expf(bs[63 * 64 + tid]);
    }
    __syncthreads();
    const int mb = wave >> 1, nb = wave & 1, lr = lane & 31, hh = lane >> 5;
    f32x16 acc;
#pragma unroll
    for (int r = 0; r < 16; ++r) acc[r] = 0.f;
#pragma unroll
    for (int ks = 0; ks < 4; ++ks) {
        const h8v a = *(const LAS h8v*)(VT + (32 * mb + lr) * GLD + 16 * ks + 8 * hh);
        const h8v bb = *(const LAS h8v*)(KDT + (32 * nb + lr) * GLD + 16 * ks + 8 * hh);
        acc = __builtin_amdgcn_mfma_f32_32x32x16_f16(a, bb, acc, 0, 0, 0);
    }
    float* Uu = U + (size_t)unit * 8192;
#pragma unroll
    for (int r = 0; r < 16; ++r) Uu[(32 * mb + (r & 3) + 8 * (r >> 2) + 4 * hh) * 64 + 32 * nb + lr] = acc[r];
}
__device__ __forceinline__ void gla_g3_unit(LAS unsigned char* lds, const f16* __restrict__ PROJ, const float* __restrict__ LA, const float* __restrict__ U, const float* __restrict__ norm_g, f16* __restrict__ YC, int unit, int tid) {
    const int lane = tid & 63, wave = __builtin_amdgcn_readfirstlane(tid >> 6);
    const int c = unit & 63, h = (unit >> 6) & 3, b = unit >> 8;
    const size_t m0 = (size_t)b * SEQ + c * 64;
    LAS float* bs = (LAS float*)lds; LAS float* tot = (LAS float*)(lds + 16384);
    LAS f16* VT = (LAS f16*)(lds + 18432); LAS unsigned short* KINV = (LAS unsigned short*)(lds + 36864); LAS f16* QD = (LAS f16*)(lds + 46080); LAS unsigned short* QD2 = (LAS unsigned short*)(lds + 55296);
    LAS f16* ST = (LAS f16*)(lds + 64512); LAS float* SS = (LAS float*)(lds + 82944);
    __syncthreads();
    gla_cumsum(bs, tot, LA + m0 * 256 + h * 64, tid);
    {
        const int s_ = tid >> 3, ch = tid & 7;
        const f16* row = PROJ + (m0 + s_) * ABP;
        const h8v qv = *(const h8v*)(row + 1536 + h * 64 + 8 * ch), kv = *(const h8v*)(row + 1792 + h * 64 + 8 * ch);
        const h8v v0 = *(const h8v*)(row + 2048 + h * 128 + 8 * ch), v1 = *(const h8v*)(row + 2048 + h * 128 + 64 + 8 * ch);
        h8v qd; bf8v q2, ki;
#pragma unroll
        for (int j = 0; j < 8; ++j) {
            const int dk = 8 * ch + j; const float bb = bs[s_ * 64 + dk], br = bs[31 * 64 + dk], q = (float)qv[j] * 0.125f;
            qd[j] = (f16)(q * __expf(bb)); q2[j] = (short)f2bf(q * __expf(bb - br)); ki[j] = (short)f2bf((float)kv[j] * __expf(br - bb));
            VT[(8 * ch + j) * GLD + s_] = v0[j]; VT[(64 + 8 * ch + j) * GLD + s_] = v1[j];
        }
        *(LAS h8v*)(QD + s_ * GLD + 8 * ch) = qd; *(LAS bf8v*)(QD2 + s_ * GLD + 8 * ch) = q2; *(LAS bf8v*)(KINV + s_ * GLD + 8 * ch) = ki;
        const float* sp = U + (size_t)unit * 8192 + (tid >> 2) * 64 + (tid & 3) * 16;
        const f32x4 s0 = *(const f32x4*)sp, s1 = *(const f32x4*)(sp + 4), s2 = *(const f32x4*)(sp + 8), s3 = *(const f32x4*)(sp + 12);
        h8v sa, sb;
        sa[0] = (f16)s0[0]; sa[1] = (f16)s0[1]; sa[2] = (f16)s0[2]; sa[3] = (f16)s0[3]; sa[4] = (f16)s1[0]; sa[5] = (f16)s1[1]; sa[6] = (f16)s1[2]; sa[7] = (f16)s1[3];
        sb[0] = (f16)s2[0]; sb[1] = (f16)s2[1]; sb[2] = (f16)s2[2]; sb[3] = (f16)s2[3]; sb[4] = (f16)s3[0]; sb[5] = (f16)s3[1]; sb[6] = (f16)s3[2]; sb[7] = (f16)s3[3];
        *(LAS h8v*)(ST + (tid >> 2) * GLD + (tid & 3) * 16) = sa; *(LAS h8v*)(ST + (tid >> 2) * GLD + (tid & 3) * 16 + 8) = sb;
    }
    __syncthreads();
    const int tb = wave & 1, dvb = wave >> 1, lr = lane & 31, hh = lane >> 5;
    f32x16 acc;
#pragma unroll
    for (int r = 0; r < 16; ++r) acc[r] = 0.f;
#pragma unroll
    for (int ks = 0; ks < 4; ++ks) {
        const h8v a = *(const LAS h8v*)(ST + (32 * dvb + lr) * GLD + 16 * ks + 8 * hh);
        const h8v bb = *(const LAS h8v*)(QD + (32 * tb + lr) * GLD + 16 * ks + 8 * hh);
        acc = __builtin_amdgcn_mfma_f32_32x32x16_f16(a, bb, acc, 0, 0, 0);
    }
    const int t_in = 32 * tb + lr;
    for (int sb = 0; sb <= tb; ++sb) {
        f32x16 at;
#pragma unroll
        for (int r = 0; r < 16; ++r) at[r] = 0.f;
#pragma unroll
        for (int ks = 0; ks < 4; ++ks) {
            const bf8v a = *(const LAS bf8v*)(KINV + (32 * sb + lr) * GLD + 16 * ks + 8 * hh);
            const bf8v bb = *(const LAS bf8v*)(QD2 + (32 * tb + lr) * GLD + 16 * ks + 8 * hh);
            at = __builtin_amdgcn_mfma_f32_32x32x16_bf16(a, bb, at, 0, 0, 0);
        }
#pragma unroll
        for (int r = 0; r < 16; ++r) { const int s_in = 32 * sb + (r & 3) + 8 * (r >> 2) + 4 * hh; if (s_in > t_in) at[r] = 0.f; }
#pragma unroll
        for (int ks = 0; ks < 2; ++ks) {
            h8v pf;
#pragma unroll
            for (int j = 0; j < 8; ++j) pf[j] = (f16)at[8 * ks + j];
            const h4v a0 = *(const LAS h4v*)(VT + (32 * dvb + lr) * GLD + 32 * sb + 16 * ks + 4 * hh), a1 = *(const LAS h4v*)(VT + (32 * dvb + lr) * GLD + 32 * sb + 16 * ks + 8 + 4 * hh);
            h8v a; a[0] = a0[0]; a[1] = a0[1]; a[2] = a0[2]; a[3] = a0[3]; a[4] = a1[0]; a[5] = a1[1]; a[6] = a1[2]; a[7] = a1[3];
            acc = __builtin_amdgcn_mfma_f32_32x32x16_f16(a, pf, acc, 0, 0, 0);
        }
    }
    float ss = 0.f;
#pragma unroll
    for (int r = 0; r < 16; ++r) ss += acc[r] * acc[r];
    ss += __shfl_xor(ss, 32);
    if (hh == 0) SS[(tb * 4 + dvb) * 32 + lr] = ss;
    __syncthreads();
    const float tot_ss = SS[(tb * 4 + 0) * 32 + lr] + SS[(tb * 4 + 1) * 32 + lr] + SS[(tb * 4 + 2) * 32 + lr] + SS[(tb * 4 + 3) * 32 + lr];
    const float rinv = rsqrtf(tot_ss * (1.f / 128.f) + RMS_EPS);
    const size_t mrow = m0 + t_in;
    const f16* grow = PROJ + mrow * ABP + 2560 + h * 128 + 32 * dvb + 4 * hh;
    f16* orow = YC + mrow * 1024 + 512 + h * 128 + 32 * dvb + 4 * hh;
    const float* ng = norm_g + h * 128 + 32 * dvb + 4 * hh;
#pragma unroll
    for (int a = 0; a < 4; ++a) {
        const h4v gv = *(const h4v*)(grow + 8 * a); const f32x4 nv = *(const f32x4*)(ng + 8 * a);
        h4v o;
#pragma unroll
        for (int e = 0; e < 4; ++e) { const float gg = (float)gv[e]; o[e] = (f16)(acc[4 * a + e] * rinv * nv[e] * (gg / (1.f + __expf(-gg)))); }
        *(h4v*)(orow + 8 * a) = o;
    }
}


template <int SRC>
__device__ __forceinline__ void conv_item(const float* W, int ldw, int K, int nvalid, const float* aux, f16* WT, int dst_row0, int k0, int n0, LAS float* scr, int lane) {
    const int nq = (lane & 7) * 4, kq = lane >> 3;
#pragma unroll
    for (int i = 0; i < 8; ++i) {
        const int kk = kq + 8 * i; f32x4 v = (f32x4){0.f, 0.f, 0.f, 0.f};
        if (SRC == 0) { if (n0 + nq < nvalid) v = *(const f32x4*)(W + (size_t)(k0 + kk) * ldw + n0 + nq); }
        else {
#pragma unroll
            for (int r = 0; r < 16; ++r) { const float a = W[(size_t)(k0 + kk) * ldw + 3072 + r]; const f32x4 b = *(const f32x4*)(aux + r * 256 + n0 + nq); v += a * b; }
        }
        scr[kk * 33 + nq] = v[0]; scr[kk * 33 + nq + 1] = v[1]; scr[kk * 33 + nq + 2] = v[2]; scr[kk * 33 + nq + 3] = v[3];
    }
    asm volatile("s_waitcnt lgkmcnt(0)" ::: "memory");
    const int c = lane & 7;
#pragma unroll
    for (int jj = 0; jj < 4; ++jj) { const int n = (lane >> 3) + 8 * jj; const LAS float* s = scr + (8 * c) * 33 + n;
        u32x4 o; o.x = pkh(s[0 * 33], s[1 * 33]); o.y = pkh(s[2 * 33], s[3 * 33]); o.z = pkh(s[4 * 33], s[5 * 33]); o.w = pkh(s[6 * 33], s[7 * 33]);
        *(u32x4*)(WT + (size_t)(dst_row0 + n) * K + k0 + 8 * c) = o; }
    asm volatile("s_waitcnt lgkmcnt(0)" ::: "memory");
}


#define XB_TMO      128
#define XB_XCNT(j)  (256  + 64 * (j))
#define XB_XSUB(j)  (1280 + 64 * (j))
#define XB_XGEN(j)  (2304 + 64 * (j))
#define XB_TOP      3328
#define XB_TOPGEN   3392
#define XCD_BAR_WORDS 3456
#define XB_SPIN_CAP (1u << 18)
__device__ __forceinline__ unsigned xb_ld(unsigned* p)              { return __hip_atomic_load(p, __ATOMIC_RELAXED, __HIP_MEMORY_SCOPE_AGENT); }
__device__ __forceinline__ unsigned xb_add(unsigned* p, unsigned v) { return __hip_atomic_fetch_add(p, v, __ATOMIC_RELAXED, __HIP_MEMORY_SCOPE_AGENT); }
__device__ __forceinline__ unsigned xb_xcc_id() { return (unsigned)__builtin_amdgcn_s_getreg((3 << 11) | 20) & 0xFu; }
#define XB_SPIN(cond, bar) do { unsigned _sp = 0; while (cond) { __builtin_amdgcn_s_sleep(1); \
    if ((++_sp & 255u) == 0u) { if (xb_ld(&(bar)[XB_TMO])) break; if (_sp > XB_SPIN_CAP) { atomicAdd(&(bar)[XB_TMO], 1u); break; } } } } while (0)
struct XcdBarrier { unsigned* bar; unsigned x; volatile LAS unsigned* st; };
__device__ __forceinline__ XcdBarrier xcd_barrier_post(unsigned* bar, volatile LAS unsigned* st) {
    XcdBarrier b; b.bar = bar; b.x = xb_xcc_id(); b.st = st;
    if (threadIdx.x == 0) (void)xb_add(&bar[XB_XCNT(b.x)], 1u);
    return b;
}
__device__ __forceinline__ void xcd_barrier_complete(unsigned* bar, unsigned x, unsigned& nloc, unsigned& nx) {
    const unsigned G = gridDim.x * gridDim.y * gridDim.z;
    unsigned sum, cnt, mine, sp = 0u;
    for (;;) {
        sum = 0u; cnt = 0u; mine = 0u;
#pragma unroll
        for (unsigned j = 0; j < 16; ++j) { const unsigned c = xb_ld(&bar[XB_XCNT(j)]); sum += c; cnt += (c > 0u) ? 1u : 0u; mine = (j == x) ? c : mine; }
        if (sum == G) break;
        __builtin_amdgcn_s_sleep(1);
        if ((++sp & 255u) == 0u) { if (xb_ld(&bar[XB_TMO])) break; if (sp > XB_SPIN_CAP) { atomicAdd(&bar[XB_TMO], 1u); break; } }
    }
    nloc = mine > 0u ? mine : 1u; nx = cnt > 0u ? cnt : 1u;
}
__device__ __forceinline__ void xcd_barrier(const XcdBarrier& b) {
    asm volatile("s_waitcnt vmcnt(0)" ::: "memory");
    __syncthreads();
    if (threadIdx.x == 0) {
        unsigned* bar = b.bar;
        __builtin_amdgcn_s_waitcnt(0);
        unsigned nloc = b.st[0], nx = b.st[1];
        if (nloc == 0u) { xcd_barrier_complete(bar, b.x, nloc, nx); b.st[0] = nloc; b.st[1] = nx; }
        const unsigned old = xb_add(&bar[XB_XSUB(b.x)], 1u);
        const unsigned gen = old / nloc;
        if (old + 1u == (gen + 1u) * nloc) {
            __builtin_amdgcn_fence(__ATOMIC_RELEASE, "agent");
            asm volatile("s_waitcnt vmcnt(0)" ::: "memory");
            const unsigned og = xb_add(&bar[XB_TOP], 1u);
            const unsigned tg = og / nx;
            if (og + 1u == (tg + 1u) * nx) xb_add(&bar[XB_TOPGEN], 1u);
            else XB_SPIN(xb_ld(&bar[XB_TOPGEN]) == tg, bar);
            __builtin_amdgcn_fence(__ATOMIC_ACQUIRE, "agent");
            xb_add(&bar[XB_XGEN(b.x)], 1u);
            asm volatile("s_waitcnt vmcnt(0)" ::: "memory");
        } else {
            XB_SPIN(xb_ld(&bar[XB_XGEN(b.x)]) == gen, bar);
            __builtin_amdgcn_fence(__ATOMIC_ACQUIRE, "agent");
            asm volatile("s_waitcnt vmcnt(0)" ::: "memory");
        }
    }
    __syncthreads();
}

template <bool MOE, bool ROUTE>
__device__ __forceinline__ void ln_phase(const float* __restrict__ xin, float* __restrict__ xout, const float* __restrict__ y, const int* __restrict__ slot,
                                         const float* __restrict__ modl, int g_off, const float* __restrict__ lng, const float* __restrict__ lnb,
                                         const float* __restrict__ modn, int sh_off, int sc_off, f16* __restrict__ H,
                                         const float* __restrict__ wr, int* __restrict__ tope, float* __restrict__ topw, int* __restrict__ posn, unsigned* __restrict__ cnt,
                                         int bx, int G, int wave, int lane) {
    for (int m = bx * 8 + wave; m < NT; m += G * 8) {
        const int b = m >> 12;
        float v[16]; float s = 0.f;
        const float* y0 = MOE ? y + (size_t)slot[m * 2] * 1024 : y + (size_t)m * 1024;
        const float* y1 = MOE ? y + (size_t)slot[m * 2 + 1] * 1024 : nullptr;
#pragma unroll
        for (int jq = 0; jq < 4; ++jq) {
            const int d = jq * 256 + lane * 4;
            const f32x4 xv = *(const f32x4*)(xin + (size_t)m * 1024 + d);
            f32x4 yv = *(const f32x4*)(y0 + d);
            if (MOE) yv += *(const f32x4*)(y1 + d);
            const f32x4 gv = *(const f32x4*)(modl + b * 6144 + g_off + d);
#pragma unroll
            for (int e = 0; e < 4; ++e) { v[jq * 4 + e] = ALPHA_DN * xv[e] + (1.f + gv[e]) * yv[e]; s += v[jq * 4 + e]; }
        }
        const float mean = wave_sum(s) * (1.f / 1024.f);
        float s2 = 0.f;
#pragma unroll
        for (int i = 0; i < 16; ++i) { v[i] -= mean; s2 += v[i] * v[i]; }
        const float rstd = rsqrtf(wave_sum(s2) * (1.f / 1024.f) + LN_EPS);
        float lg[8];
#pragma unroll
        for (int e = 0; e < 8; ++e) lg[e] = 0.f;
#pragma unroll
        for (int jq = 0; jq < 4; ++jq) {
            const int d = jq * 256 + lane * 4;
            const f32x4 gg = *(const f32x4*)(lng + d), bb = *(const f32x4*)(lnb + d);
            f32x4 o;
#pragma unroll
            for (int e = 0; e < 4; ++e) o[e] = v[jq * 4 + e] * rstd * gg[e] + bb[e];
            *(f32x4*)(xout + (size_t)m * 1024 + d) = o;
            if (H) {
                const f32x4 sc = *(const f32x4*)(modn + b * 6144 + sc_off + d), sh = *(const f32x4*)(modn + b * 6144 + sh_off + d);
                f32x4 hv;
#pragma unroll
                for (int e = 0; e < 4; ++e) hv[e] = o[e] * (1.f + sc[e]) + sh[e];
                u32x2 w; w.x = pkh(hv[0], hv[1]); w.y = pkh(hv[2], hv[3]);
                *(u32x2*)(H + (size_t)m * 1024 + d) = w;
                if (ROUTE) {
#pragma unroll
                    for (int e = 0; e < 4; ++e) { const f32x4 w0 = *(const f32x4*)(wr + (d + e) * 8), w1 = *(const f32x4*)(wr + (d + e) * 8 + 4);
                        lg[0] += hv[e] * w0[0]; lg[1] += hv[e] * w0[1]; lg[2] += hv[e] * w0[2]; lg[3] += hv[e] * w0[3];
                        lg[4] += hv[e] * w1[0]; lg[5] += hv[e] * w1[1]; lg[6] += hv[e] * w1[2]; lg[7] += hv[e] * w1[3]; }
                }
            }
        }
        if (ROUTE) {
#pragma unroll
            for (int e = 0; e < 8; ++e) lg[e] = wave_sum(lg[e]);
            if (lane == 0) {
                int e0 = 0; float l0 = lg[0];
#pragma unroll
                for (int e = 1; e < 8; ++e) if (lg[e] > l0) { l0 = lg[e]; e0 = e; }
                int e1 = -1; float l1 = -INFINITY;
#pragma unroll
                for (int e = 0; e < 8; ++e) if (e != e0 && lg[e] > l1) { l1 = lg[e]; e1 = e; }
                const float w0 = 1.f / (1.f + expf(l1 - l0)), w1 = 1.f - w0;
                tope[m * 2] = e0; tope[m * 2 + 1] = e1; topw[m * 2] = w0; topw[m * 2 + 1] = w1;
                posn[m * 2] = (int)atomicAdd(cnt + e0, 1u);
                posn[m * 2 + 1] = (int)atomicAdd(cnt + e1, 1u);
            }
        }
    }
}
__device__ __forceinline__ void moe_offsets(LAS unsigned* moff, LAS unsigned* texp, const unsigned* __restrict__ cnt, int tid) {
    if (tid == 0) { unsigned off = 0; for (int e = 0; e < 8; ++e) { moff[e] = off; off += ((cnt[e] + 255u) >> 8) << 8; } moff[8] = off; }
    __syncthreads();
    if (tid < MOE_ROWS / 256) { unsigned ex = 0; for (int e = 0; e < 8; ++e) if ((unsigned)tid * 256u >= moff[e] && (unsigned)tid * 256u < moff[e + 1]) ex = e + 1; texp[tid] = ex; }
    __syncthreads();
}
__device__ __forceinline__ void compress_unit(LAS unsigned char* lds, const f16* __restrict__ PROJ, const f16* __restrict__ W1T, const f16* __restrict__ W2T, const float* __restrict__ PBv,
                                              f16* __restrict__ OUT, int which, int b, int g, int rt, int tid) {
    const int lane = tid & 63, wave = __builtin_amdgcn_readfirstlane(tid >> 6), lr = lane & 31, hh = lane >> 5;
    LAS float* part = (LAS float*)lds;
    __syncthreads();
    const int n = min(rt * 32 + lr, 254);
    const f16* arow = PROJ + ((size_t)b * SEQ + 16 * n) * NSP + (which ? 1280 : 1024) + g * 128 + 8 * hh;
    f32x16 acc[4];
#pragma unroll
    for (int nb = 0; nb < 4; ++nb)
#pragma unroll
        for (int r = 0; r < 16; ++r) acc[nb][r] = 0.f;
#pragma unroll 2
    for (int ks = 0; ks < 32; ++ks) {
        const int l = 4 * wave + (ks >> 3), d0 = 16 * (ks & 7);
        const h8v a = *(const h8v*)(arow + (size_t)l * NSP + d0);
#pragma unroll
        for (int nb = 0; nb < 4; ++nb) {
            const h8v bb = *(const h8v*)(W1T + (size_t)(32 * nb + lr) * 4096 + l * 128 + d0 + 8 * hh);
            acc[nb] = __builtin_amdgcn_mfma_f32_32x32x16_f16(a, bb, acc[nb], 0, 0, 0);
        }
    }
#pragma unroll
    for (int nb = 0; nb < 4; ++nb)
#pragma unroll
        for (int r = 0; r < 16; ++r) part[((wave * 4 + nb) * 16 + r) * 64 + lane] = acc[nb][r];
    __syncthreads();
    float hsum[8];
#pragma unroll
    for (int i = 0; i < 8; ++i) { const int item = (tid >> 6) + 8 * i; float sacc = 0.f;
#pragma unroll
        for (int w = 0; w < 8; ++w) sacc += part[(w * 64 + item) * 64 + lane];
        hsum[i] = sacc; }
    __syncthreads();
    LAS f16* HID = (LAS f16*)lds;
#pragma unroll
    for (int i = 0; i < 8; ++i) { const int item = (tid >> 6) + 8 * i, nb = item >> 4, r = item & 15; const int mrow = (r & 3) + 8 * (r >> 2) + 4 * hh, col = 32 * nb + lr;
        const float hv = hsum[i] + PBv[col]; HID[mrow * 136 + col] = (f16)(hv / (1.f + __expf(-hv))); }
    __syncthreads();
    if (wave < 4) {
        f32x16 o;
#pragma unroll
        for (int r = 0; r < 16; ++r) o[r] = 0.f;
#pragma unroll
        for (int ks = 0; ks < 8; ++ks) {
            const h8v a = *(const LAS h8v*)(HID + lr * 136 + 16 * ks + 8 * hh);
            const h8v bb = *(const h8v*)(W2T + (size_t)(32 * wave + lr) * 128 + 16 * ks + 8 * hh);
            o = __builtin_amdgcn_mfma_f32_32x32x16_f16(a, bb, o, 0, 0, 0);
        }
        f16* ob = OUT + ((size_t)(b * 2 + g) * 256 + rt * 32) * 128 + 32 * wave + lr;
#pragma unroll
        for (int r = 0; r < 16; ++r) ob[(size_t)((r & 3) + 8 * (r >> 2) + 4 * hh) * 128] = (f16)o[r];
    }
}

struct MArgs { const float* in[26]; float* out; unsigned char* ws; int ph_lo, ph_hi; };
constexpr int NPHASE = 2 + 2 * 18;

__global__ void __launch_bounds__(512, 2) mega(MArgs a) {
    extern __shared__ __attribute__((aligned(16))) unsigned char lds_raw[];
    LAS unsigned char* lds = (LAS unsigned char*)lds_raw;
    const int tid = threadIdx.x, lane = tid & 63, wave = __builtin_amdgcn_readfirstlane(tid >> 6);
    const int G = gridDim.x; const int bx = blockIdx.x;
    unsigned char* ws = a.ws;
    unsigned* ctl = (unsigned*)(ws + WS_CTL);
    float* MOD = (float*)(ws + WS_MOD); float* BIAS2 = (float*)(ws + WS_BIAS2); float* KMEAN = (float*)(ws + WS_KMEAN);
    f16* KCMP = (f16*)(ws + WS_KCMP); f16* VCMP = (f16*)(ws + WS_VCMP);
    int* TOPE = (int*)(ws + WS_TOPE); float* TOPW = (float*)(ws + WS_TOPW); int* POSN = (int*)(ws + WS_POSN); int* SLOT = (int*)(ws + WS_SLOT); float* ROWW = (float*)(ws + WS_ROWW);
    f16* H = (f16*)(ws + WS_H); f16* PROJ = (f16*)(ws + WS_PROJ); float* LA = (float*)(ws + WS_LA); f16* YCAT = (f16*)(ws + WS_YCAT); float* Y = (float*)(ws + WS_Y);
    f16* FFI = (f16*)(ws + WS_FFI); f16* INTER = (f16*)(ws + WS_INTER); float* YA = (float*)(ws + WS_YA); float* GATES = (float*)(ws + WS_GATES); f16* XG = (f16*)(ws + WS_XG);
    float* X = a.out; const float* x_in = a.in[0];
    for (int u = tid; u < (LDS_BYTES - LDSCTL_OFF) / 4; u += 512) ((LAS unsigned*)(lds + LDSCTL_OFF))[u] = 0u;
    __syncthreads();
    LAS unsigned* texp = (LAS unsigned*)(lds + TEXP_OFF); LAS unsigned* moff = (LAS unsigned*)(lds + MOFF_OFF);
#if MK_SPLIT
    XcdBarrier bar; bar.bar = nullptr; bar.x = 0; bar.st = nullptr;
#define GRID_BAR() do { } while (0)
#else
    XcdBarrier bar = xcd_barrier_post(ctl + CW_BAR, (volatile LAS unsigned*)(lds + XB_ST_OFF));
#define GRID_BAR() xcd_barrier(bar)
#endif
    const int lo = a.ph_lo, hi = a.ph_hi;
#define IN(k) (lo <= (k) && (k) < hi)
#define PH_LOCALS int tid = threadIdx.x; asm volatile("" : "+v"(tid)); const int lane = tid & 63, wave = __builtin_amdgcn_readfirstlane(tid >> 6); (void)lane; (void)wave;
#define SEAM(k) do { if (IN(k) && IN((k) + 1)) GRID_BAR(); } while (0)

    if (IN(0)) {
        LAS float* cond = (LAS float*)lds; LAS float* part = (LAS float*)(lds + 16384);
        for (int i = tid; i < 4096; i += 512) { const float v = a.in[1][i]; cond[i] = v / (1.f + expf(-v)); }
        __syncthreads();
        for (int task = bx; task < 768; task += G) {
            const int i = task / 192, n0 = (task % 192) * 32, ksub = lane >> 5;
            const float* w = a.in[3] + (size_t)i * 1024 * 6144 + n0 + (lane & 31);
            float a0 = 0.f, a1 = 0.f, a2 = 0.f, a3 = 0.f;
#pragma unroll 8
            for (int it = 0; it < 64; ++it) { const int k = 128 * wave + 2 * it + ksub; const float wv = w[(size_t)k * 6144];
                a0 += cond[k] * wv; a1 += cond[1024 + k] * wv; a2 += cond[2048 + k] * wv; a3 += cond[3072 + k] * wv; }
            a0 += __shfl_xor(a0, 32); a1 += __shfl_xor(a1, 32); a2 += __shfl_xor(a2, 32); a3 += __shfl_xor(a3, 32);
            if (lane < 32) { part[(wave * 4 + 0) * 32 + lane] = a0; part[(wave * 4 + 1) * 32 + lane] = a1; part[(wave * 4 + 2) * 32 + lane] = a2; part[(wave * 4 + 3) * 32 + lane] = a3; }
            __syncthreads();
            if (tid < 128) { const int b = tid >> 5, l = tid & 31; float sacc = 0.f;
#pragma unroll
                for (int w8 = 0; w8 < 8; ++w8) sacc += part[(w8 * 4 + b) * 32 + l];
                MOD[(i * 4 + b) * 6144 + n0 + l] = sacc + a.in[4][i * 6144 + n0 + l]; }
            __syncthreads();
        }
        for (int idx = bx * 512 + tid; idx < 8192; idx += G * 512) { const int h = idx >> 10, dist = idx & 1023; BIAS2[idx] = a.in[2][t5_bucket(dist) * 8 + h] * 1.4426950408889634f; }
        LAS float* scr = (LAS float*)(lds + wave * 16384);
        const int gw = bx * 8 + wave, NGW = G * 8;
        constexpr int I_ABIN = 16 * 96, I_W12 = 16 * 8, I_SQ = 16 * 32, I_FUP1 = 16 * 88, I_FDN = 44 * 32, I_NSIN = 16 * 88, I_W1C = 64 * 4, I_W2C = 2 * 4, I_PB = 256;
        constexpr int NIT = I_ABIN + I_W12 + I_SQ + 2 * I_FUP1 + I_FDN + I_NSIN + I_SQ + 2 * I_W1C + 2 * I_W2C + I_PB;
        for (int it = gw; it < 2 * NIT; it += NGW) {
            const int j = it / NIT; int r = it % NIT;
            const float* ab_w_in = a.in[7] + (size_t)j * 1024 * ABW;
            if (r < I_ABIN) { const int kb = r / 96, nb = r % 96; conv_item<0>(ab_w_in, ABW, 1024, 3072, nullptr, (f16*)(ws + WT_ABIN + j * SZ_ABIN), nb * 32, kb * 64, nb * 32, scr, lane); continue; } r -= I_ABIN;
            if (r < I_W12) { const int kb = r / 8, nb = r % 8; conv_item<1>(ab_w_in, ABW, 1024, 256, a.in[8] + j * 16 * 256, (f16*)(ws + WT_ABIN + j * SZ_ABIN), 3072 + nb * 32, kb * 64, nb * 32, scr, lane); continue; } r -= I_W12;
            if (r < I_SQ) { const int kb = r / 32, nb = r % 32; conv_item<0>(a.in[11] + (size_t)j * 1024 * 1024, 1024, 1024, 1024, nullptr, (f16*)(ws + WT_ABOUT + j * SZ_SQ), nb * 32, kb * 64, nb * 32, scr, lane); continue; } r -= I_SQ;
            if (r < 2 * I_FUP1) { const int which = r / I_FUP1; r %= I_FUP1; const int kb = r / 88, nb = r % 88, n0 = nb * 32;
                conv_item<0>((which ? a.in[13] : a.in[12]) + (size_t)j * 1024 * DFF, DFF, 1024, DFF, nullptr, (f16*)(ws + WT_FUP + j * SZ_FUP), (n0 >> 7) * 256 + (n0 & 127) + which * 128, kb * 64, n0, scr, lane); continue; } r -= 2 * I_FUP1;
            if (r < I_FDN) { const int kb = r / 32, nb = r % 32; conv_item<0>(a.in[14] + (size_t)j * DFF * 1024, 1024, DFF, 1024, nullptr, (f16*)(ws + WT_FDN + j * SZ_FDN), nb * 32, kb * 64, nb * 32, scr, lane); continue; } r -= I_FDN;
            if (r < I_NSIN) { const int kb = r / 88, nb = r % 88; conv_item<0>(a.in[15] + (size_t)j * 1024 * NSW, NSW, 1024, NSW, nullptr, (f16*)(ws + WT_NSIN + j * SZ_NSIN), nb * 32, kb * 64, nb * 32, scr, lane); continue; } r -= I_NSIN;
            if (r < I_SQ) { const int kb = r / 32, nb = r % 32; conv_item<0>(a.in[21] + (size_t)j * 1024 * 1024, 1024, 1024, 1024, nullptr, (f16*)(ws + WT_NSOUT + j * SZ_SQ), nb * 32, kb * 64, nb * 32, scr, lane); continue; } r -= I_SQ;
            if (r < 2 * I_W1C) { const int which = r / I_W1C; r %= I_W1C; const int kb = r / 4, nb = r % 4;
                conv_item<0>((which ? a.in[19] : a.in[17]) + (size_t)j * 4096 * 128, 128, 4096, 128, nullptr, (f16*)(ws + WT_W1C) + (size_t)(j * 2 + which) * 128 * 4096, nb * 32, kb * 64, nb * 32, scr, lane); continue; } r -= 2 * I_W1C;
            if (r < 2 * I_W2C) { const int which = r / I_W2C; r %= I_W2C; const int kb = r / 4, nb = r % 4;
                conv_item<0>((which ? a.in[20] : a.in[18]) + (size_t)j * 128 * 128, 128, 128, 128, nullptr, (f16*)(ws + WT_W2C) + (size_t)(j * 2 + which) * 128 * 128, nb * 32, kb * 64, nb * 32, scr, lane); continue; } r -= 2 * I_W2C;
            { const int which = r >> 7, c = r & 127; const float* pos = a.in[16] + j * 4096; const float* w1 = (which ? a.in[19] : a.in[17]) + (size_t)j * 4096 * 128 + c; float sacc = 0.f;
                for (int k = lane; k < 4096; k += 64) sacc += pos[k] * w1[(size_t)k * 128];
                sacc = wave_sum(sacc); if (lane == 0) ((float*)(ws + WS_PB))[(j * 2 + which) * 128 + c] = sacc; }
        }
    }
    SEAM(0);
    if (IN(1)) {
        for (size_t i8 = (size_t)bx * 512 + tid; i8 < (size_t)NT * 128; i8 += (size_t)G * 512) {
            const size_t idx = i8 * 8; const int d = (int)(idx & 1023), b = (int)(idx >> 22);
            const f32x4 x0 = *(const f32x4*)(x_in + idx), x1 = *(const f32x4*)(x_in + idx + 4);
            const float* mb = MOD + b * 6144;
            const f32x4 s0 = *(const f32x4*)(mb + 1024 + d), s1 = *(const f32x4*)(mb + 1024 + d + 4), h0 = *(const f32x4*)(mb + d), h1 = *(const f32x4*)(mb + d + 4);
            u32x4 w; w.x = pkh(x0[0] * (1.f + s0[0]) + h0[0], x0[1] * (1.f + s0[1]) + h0[1]); w.y = pkh(x0[2] * (1.f + s0[2]) + h0[2], x0[3] * (1.f + s0[3]) + h0[3]);
            w.z = pkh(x1[0] * (1.f + s1[0]) + h1[0], x1[1] * (1.f + s1[1]) + h1[1]); w.w = pkh(x1[2] * (1.f + s1[2]) + h1[2], x1[3] * (1.f + s1[3]) + h1[3]);
            *(u32x4*)(H + idx) = w;
        }
    }
    SEAM(1);
    for (int j_ = 0; j_ < 2; ++j_) {
        int j = j_; asm volatile("" : "+s"(j));
        unsigned long long wsv_ = (unsigned long long)a.ws; asm volatile("" : "+s"(wsv_)); unsigned char* ws = (unsigned char*)wsv_;
        int tid = threadIdx.x; asm volatile("" : "+v"(tid)); const int lane = tid & 63, wave = __builtin_amdgcn_readfirstlane(tid >> 6);
        int G = gridDim.x, bx = blockIdx.x; asm volatile("" : "+s"(G), "+s"(bx));
        unsigned* ctl = (unsigned*)(ws + WS_CTL);
        float* MOD = (float*)(ws + WS_MOD); float* BIAS2 = (float*)(ws + WS_BIAS2); float* KMEAN = (float*)(ws + WS_KMEAN);
        f16* KCMP = (f16*)(ws + WS_KCMP); f16* VCMP = (f16*)(ws + WS_VCMP);
        int* TOPE = (int*)(ws + WS_TOPE); float* TOPW = (float*)(ws + WS_TOPW); int* POSN = (int*)(ws + WS_POSN); int* SLOT = (int*)(ws + WS_SLOT); float* ROWW = (float*)(ws + WS_ROWW);
        f16* H = (f16*)(ws + WS_H); f16* PROJ = (f16*)(ws + WS_PROJ); float* LA = (float*)(ws + WS_LA); f16* YCAT = (f16*)(ws + WS_YCAT); float* Y = (float*)(ws + WS_Y);
        f16* FFI = (f16*)(ws + WS_FFI); f16* INTER = (f16*)(ws + WS_INTER); float* YA = (float*)(ws + WS_YA); float* GATES = (float*)(ws + WS_GATES); f16* XG = (f16*)(ws + WS_XG);
        const int pb = 2 + 18 * j;
        const int ie = 2 * j, io = 2 * j + 1;
        const float* mode = MOD + (size_t)ie * 4 * 6144; const float* modo = MOD + (size_t)io * 4 * 6144;
        const float* modn = MOD + (size_t)(io + 1 < DEPTH ? io + 1 : io) * 4 * 6144;
        if (IN(pb + 0)) { PH_LOCALS
            pg8::Gemm g{H, (const f16*)(ws + WT_ABIN + j * SZ_ABIN), NT, 3328, 1024}; pg8::StaticOrder S; S.init(NT, 3328, G, bx);
            pg8::EpiIn<0> E{PROJ, 12, LA, a.in[9] + j * 256};
            pg8::gemm_phase<pg8::EpiIn<0>, pg8::StaticOrder, true, true>(lds, g, S, E, tid);
        }
        SEAM(pb + 0);
        if (IN(pb + 1)) { PH_LOCALS
            for (int u = bx * 8 + wave; u < 512; u += G * 8) {
                const int n = u & 15, h = (u >> 4) & 7, b = u >> 7;
                const f16* kp = PROJ + (size_t)(b * SEQ + n * 256) * ABP + 512 + h * 64 + lane;
                float s0 = 0.f, s1 = 0.f, s2 = 0.f, s3 = 0.f;
#pragma unroll 4
                for (int r = 0; r < 256; r += 4) { s0 += (float)kp[(size_t)r * ABP]; s1 += (float)kp[(size_t)(r + 1) * ABP]; s2 += (float)kp[(size_t)(r + 2) * ABP]; s3 += (float)kp[(size_t)(r + 3) * ABP]; }
                KMEAN[u * 64 + lane] = ((s0 + s1) + (s2 + s3)) * (1.f / 256.f);
            }
            for (int u = bx; u < 1024; u += G) gla_g1_unit(lds, PROJ, LA, (float*)(ws + WS_GLAO), (float*)(ws + WS_DC), u, tid);
        }
        SEAM(pb + 1);
        if (IN(pb + 2)) { PH_LOCALS
            { float* U = (float*)(ws + WS_GLAO); const float* Dc = (const float*)(ws + WS_DC);
              for (int e = bx * 512 + tid; e < 16 * 8192; e += G * 512) {
                  const int bh = e >> 13, el = e & 8191, dk = el & 63;
                  float carry = 0.f;
#pragma unroll 8
                  for (int c = 0; c < 64; ++c) { const size_t idx = ((size_t)(bh * 64 + c)) * 8192 + el; const float u = U[idx]; U[idx] = carry; carry = Dc[(bh * 64 + c) * 64 + dk] * carry + u; }
              } }
            for (int p = bx; p < 256; p += G) {
                const int bh = p >> 3, qlo = p & 7;
#pragma unroll 1
                for (int k = 0; k < 2; ++k) moba_unit(lds, PROJ, KMEAN, BIAS2, YCAT, bh >> 3, bh & 7, k ? qlo : 15 - qlo, tid);
            }
        }
        SEAM(pb + 2);
        if (IN(pb + 3)) { PH_LOCALS for (int u = bx; u < 1024; u += G) gla_g3_unit(lds, PROJ, LA, (const float*)(ws + WS_GLAO), a.in[10] + j * 512, YCAT, u, tid); }
        SEAM(pb + 3);
        if (IN(pb + 4)) { PH_LOCALS
            pg8::Gemm g{YCAT, (const f16*)(ws + WT_ABOUT + j * SZ_SQ), NT, 1024, 1024}; pg8::StaticOrder S; S.init(NT, 1024, G, bx);
            pg8::EpiF32 E{Y, 1024, nullptr};
            pg8::gemm_phase<pg8::EpiF32, pg8::StaticOrder, false, true>(lds, g, S, E, tid);
        }
        SEAM(pb + 4);
        if (IN(pb + 5)) { PH_LOCALS ln_phase<false, false>(j == 0 ? x_in : X, X, Y, nullptr, mode, 2048, a.in[5] + (ie * 2 + 0) * 1024, a.in[6] + (ie * 2 + 0) * 1024, mode, 3072, 4096, H, nullptr, nullptr, nullptr, nullptr, nullptr, bx, G, wave, lane); }
        SEAM(pb + 5);
        if (IN(pb + 6)) { PH_LOCALS
            pg8::Gemm g{H, (const f16*)(ws + WT_FUP + j * SZ_FUP), NT, 5632, 1024}; pg8::StaticOrder S; S.init(NT, 5632, G, bx);
            pg8::EpiSwiglu E{FFI, DFF};
            pg8::gemm_phase<pg8::EpiSwiglu, pg8::StaticOrder, true, true>(lds, g, S, E, tid);
        }
        SEAM(pb + 6);
        if (IN(pb + 7)) { PH_LOCALS
            pg8::Gemm g{FFI, (const f16*)(ws + WT_FDN + j * SZ_FDN), NT, 1024, DFF}; pg8::StaticOrder S; S.init(NT, 1024, G, bx);
            pg8::EpiF32 E{Y, 1024, nullptr};
            pg8::gemm_phase<pg8::EpiF32, pg8::StaticOrder, false, true>(lds, g, S, E, tid);
        }
        SEAM(pb + 7);
        if (IN(pb + 8)) { PH_LOCALS ln_phase<false, false>(X, X, Y, nullptr, mode, 5120, a.in[5] + (ie * 2 + 1) * 1024, a.in[6] + (ie * 2 + 1) * 1024, modo, 0, 1024, H, nullptr, nullptr, nullptr, nullptr, nullptr, bx, G, wave, lane); }
        SEAM(pb + 8);
        if (IN(pb + 9)) { PH_LOCALS
            pg8::Gemm g{H, (const f16*)(ws + WT_NSIN + j * SZ_NSIN), NT, 2816, 1024}; pg8::StaticOrder S; S.init(NT, 2816, G, bx);
            pg8::EpiIn<1> E{PROJ, 10, GATES, nullptr};
            pg8::gemm_phase<pg8::EpiIn<1>, pg8::StaticOrder, true, true>(lds, g, S, E, tid);
        }
        SEAM(pb + 9);
        if (IN(pb + 10)) { PH_LOCALS
            for (int u = bx; u < 128; u += G) {
                const int rt = u & 7, g2 = (u >> 3) & 1, b = (u >> 4) & 3, which = u >> 6;
                compress_unit(lds, PROJ, (const f16*)(ws + WT_W1C) + (size_t)(j * 2 + which) * 128 * 4096, (const f16*)(ws + WT_W2C) + (size_t)(j * 2 + which) * 128 * 128,
                              (const float*)(ws + WS_PB) + (j * 2 + which) * 128, which ? VCMP : KCMP, which, b, g2, rt, tid);
            }
            __syncthreads();
            LAS float* scr = (LAS float*)(lds + wave * 16384);
            constexpr int I_MUP1 = 16 * 112, I_MDN = 56 * 32, NITM = 8 * 2 * I_MUP1 + 8 * I_MDN;
            const float* mw1 = a.in[23] + (size_t)j * 8 * 1024 * DFE; const float* mw3 = a.in[24] + (size_t)j * 8 * 1024 * DFE; const float* mw2 = a.in[25] + (size_t)j * 8 * DFE * 1024;
            for (int it = (G - 1 - bx) * 8 + wave; it < NITM; it += G * 8) {
                int r = it;
                if (r < 16 * I_MUP1) { const int e = r / (2 * I_MUP1); r %= 2 * I_MUP1; const int which = r / I_MUP1; r %= I_MUP1; const int kb = r / 112, nb = r % 112, n0 = nb * 32;
                    conv_item<0>((which ? mw3 : mw1) + (size_t)e * 1024 * DFE, DFE, 1024, DFE, nullptr, (f16*)(ws + WT_MUP) + (size_t)e * 7168 * 1024, (n0 >> 7) * 256 + (n0 & 127) + which * 128, kb * 64, n0, scr, lane); continue; } r -= 16 * I_MUP1;
                { const int e = r / I_MDN; r %= I_MDN; const int kb = r / 32, nb = r % 32; conv_item<0>(mw2 + (size_t)e * DFE * 1024, 1024, DFE, 1024, nullptr, (f16*)(ws + WT_MDN) + (size_t)e * 1024 * 3584, nb * 32, kb * 64, nb * 32, scr, lane); }
            }
        }
        SEAM(pb + 10);
        if (IN(pb + 11)) { PH_LOCALS
            for (int p = bx; p < 256; p += G) {
                const int bg = p >> 5, qlo = p & 31;
#pragma unroll 1
                for (int k = 0; k < 2; ++k) nsa_unit(lds, PROJ, GATES, KCMP, VCMP, BIAS2, YCAT, bg >> 1, bg & 1, k ? qlo : 63 - qlo, tid);
            }
        }
        SEAM(pb + 11);
        if (IN(pb + 12)) { PH_LOCALS
            pg8::Gemm g{YCAT, (const f16*)(ws + WT_NSOUT + j * SZ_SQ), NT, 1024, 1024}; pg8::StaticOrder S; S.init(NT, 1024, G, bx);
            pg8::EpiF32 E{Y, 1024, nullptr};
            pg8::gemm_phase<pg8::EpiF32, pg8::StaticOrder, false, true>(lds, g, S, E, tid);
        }
        SEAM(pb + 12);
        if (IN(pb + 13)) { PH_LOCALS ln_phase<false, true>(X, X, Y, nullptr, modo, 2048, a.in[5] + (io * 2 + 0) * 1024, a.in[6] + (io * 2 + 0) * 1024, modo, 3072, 4096, H, a.in[22] + j * 8192, TOPE, TOPW, POSN, ctl + CW_CNT + 16 * j, bx, G, wave, lane); }
        SEAM(pb + 13);
        if (IN(pb + 14)) { PH_LOCALS
            moe_offsets(moff, texp, ctl + CW_CNT + 16 * j, tid);
            for (int i = bx * 8 + wave; i < 2 * NT; i += G * 8) {
                const int e = TOPE[i]; const int sl = (int)moff[e] + POSN[i];
                if (lane == 0) { SLOT[i] = sl; ROWW[sl] = TOPW[i]; }
                const u32x4* src = (const u32x4*)(H + (size_t)(i >> 1) * 1024); u32x4* dst = (u32x4*)(XG + (size_t)sl * 1024);
                dst[lane] = src[lane]; dst[lane + 64] = src[lane + 64];
            }
        }
        SEAM(pb + 14);
        if (IN(pb + 15)) { PH_LOCALS
            moe_offsets(moff, texp, ctl + CW_CNT + 16 * j, tid);
            pg8::Gemm g{XG, (const f16*)(ws + WT_MUP), MOE_ROWS, 7168, 1024}; pg8::MoeOrder S; S.init((int)moff[8], 7168, G, bx); S.texp = texp; S.estride = SZ_MUP;
            pg8::EpiSwiglu E{INTER, DFE};
            pg8::gemm_phase<pg8::EpiSwiglu, pg8::MoeOrder, true, true>(lds, g, S, E, tid);
        }
        SEAM(pb + 15);
        if (IN(pb + 16)) { PH_LOCALS
            moe_offsets(moff, texp, ctl + CW_CNT + 16 * j, tid);
            pg8::Gemm g{INTER, (const f16*)(ws + WT_MDN), MOE_ROWS, 1024, DFE}; pg8::MoeOrder S; S.init((int)moff[8], 1024, G, bx); S.texp = texp; S.estride = SZ_MDN;
            pg8::EpiF32 E{YA, 1024, ROWW};
            pg8::gemm_phase<pg8::EpiF32, pg8::MoeOrder, false, true>(lds, g, S, E, tid);
        }
        SEAM(pb + 16);
        if (IN(pb + 17)) { PH_LOCALS ln_phase<true, false>(X, X, YA, SLOT, modo, 5120, a.in[5] + (io * 2 + 1) * 1024, a.in[6] + (io * 2 + 1) * 1024, modn, 0, 1024, (io + 1 < DEPTH) ? H : (f16*)nullptr, nullptr, nullptr, nullptr, nullptr, nullptr, bx, G, wave, lane); }
        if (j == 0) SEAM(pb + 17);
    }
#undef IN
#undef SEAM
#undef GRID_BAR
}

extern "C" void kernel_launch(void* const* d_in, const int* in_sizes, int n_in, void* d_out, int out_size, void* d_ws, size_t ws_size, hipStream_t stream) {
    if (n_in != 26 || ws_size < WT_END) { fprintf(stderr, "kernel_launch: unexpected n_in %d / ws_size %zu (need %zu)\n", n_in, ws_size, (size_t)WT_END); return; }
    static int grid = 0;
    if (!grid) {
        int dev = 0, cus = 0;
        (void)hipGetDevice(&dev); (void)hipDeviceGetAttribute(&cus, hipDeviceAttributeMultiprocessorCount, dev);
        (void)hipFuncSetAttribute((const void*)mega, hipFuncAttributeMaxDynamicSharedMemorySize, LDS_BYTES);
        grid = cus > 0 ? cus : 256;
        if (grid > 256) grid = 256;
    }
    (void)hipMemsetAsync((char*)d_ws + WS_CTL, 0, CTL_BYTES, stream);
    MArgs ma{}; for (int i = 0; i < 26; ++i) ma.in[i] = (const float*)d_in[i]; ma.out = (float*)d_out; ma.ws = (unsigned char*)d_ws;
#if MK_SPLIT
    for (int ph = 0; ph < NPHASE; ++ph) { ma.ph_lo = ph; ma.ph_hi = ph + 1; hipLaunchKernelGGL(mega, dim3(grid), dim3(512), LDS_BYTES, stream, ma); }
#else
    ma.ph_lo = 0; ma.ph_hi = NPHASE;
    hipLaunchKernelGGL(mega, dim3(grid), dim3(512), LDS_BYTES, stream, ma);
#endif
}
```
